# Optimizing an MI355X kernel written in HIP

```python
import math
import numpy as np
import jax, jax.numpy as jnp
from jax import lax

D_MODEL = 1024
BATCH = 8
SEQ = 4096
DEPTH = 4

DN_HEADS = 4
DN_HEAD_DIM = 128
DN_WIDTH = DN_HEADS * DN_HEAD_DIM
DN_CONV = 4
DN_CHUNK = 64
SWA_HEADS = 8
SWA_HEAD_DIM = 64
SWA_WIDTH = SWA_HEADS * SWA_HEAD_DIM
DILATED_CONFIGS = ((128, 1), (512, 4), (2048, 16))
ATTN_BLOCK = 128
ROPE_THETA = 500000.0
ROPE_DIM = SWA_HEAD_DIM // 4
D_MIX = DN_WIDTH + SWA_WIDTH
IN_SPLITS = (3 * DN_WIDTH, DN_WIDTH, DN_HEADS, DN_HEADS, SWA_WIDTH, SWA_WIDTH, SWA_WIDTH)
IN_WIDTH = sum(IN_SPLITS)
D_FF = 2816
FFN_CONV = 3
NORM_EPS = 1e-6

kernel_name = "hymba_style_deltanet_dilated_swa_convglu"


def _rmsnorm(x, w):
    xf = x.astype(jnp.float32)
    y = xf * lax.rsqrt(jnp.mean(xf * xf, axis=-1, keepdims=True) + NORM_EPS)
    return (y * w.astype(jnp.float32)).astype(x.dtype)


def _l2norm(x):
    xf = x.astype(jnp.float32)
    return xf * lax.rsqrt(jnp.sum(xf * xf, axis=-1, keepdims=True) + NORM_EPS)


def _causal_dwconv(x, w):
    K = w.shape[0]
    S = x.shape[1]
    xp = jnp.pad(x, ((0, 0), (K - 1, 0), (0, 0)))
    y = xp[:, 0:S] * w[0]
    for j in range(1, K):
        y = y + xp[:, j:j + S] * w[j]
    return y


def _rope_tables(S):
    pos = jnp.arange(S, dtype=jnp.float32)
    inv_freq = ROPE_THETA ** (-jnp.arange(0, ROPE_DIM, 2, dtype=jnp.float32) / ROPE_DIM)
    ang = pos[:, None] * inv_freq[None, :]
    return jnp.cos(ang), jnp.sin(ang)


def _partial_rope(x, cos, sin):
    half = ROPE_DIM // 2
    c = cos[None, :, None, :].astype(x.dtype)
    s = sin[None, :, None, :].astype(x.dtype)
    x1, x2, rest = x[..., :half], x[..., half:ROPE_DIM], x[..., ROPE_DIM:]
    return jnp.concatenate([x1 * c - x2 * s, x2 * c + x1 * s, rest], axis=-1)


def _gated_delta_rule(q, k, v, g, beta):
    B, S, H, Dk = q.shape
    Dv = v.shape[-1]
    C = DN_CHUNK
    n = S // C
    f32 = jnp.float32

    def chunks(t):
        return t.astype(f32).reshape(B, n, C, H, -1).transpose(0, 3, 1, 2, 4)

    q = chunks(q) * (Dk ** -0.5)
    k = chunks(k)
    v = chunks(v)
    g = g.astype(f32).reshape(B, n, C, H).transpose(0, 3, 1, 2)
    beta = beta.astype(f32).reshape(B, n, C, H).transpose(0, 3, 1, 2)
    G = jnp.cumsum(g, axis=-1)
    idx = jnp.arange(C)
    incl = idx[:, None] >= idx[None, :]
    strict = idx[:, None] > idx[None, :]
    gamma = jnp.exp(jnp.where(incl, G[..., :, None] - G[..., None, :], -jnp.inf))
    kb = k * beta[..., None]
    a_kk = jnp.where(strict, jnp.einsum('bhnid,bhnjd->bhnij', kb, k) * gamma, 0.0)
    tri = a_kk + jnp.eye(C, dtype=f32)
    rhs = jnp.concatenate([v * beta[..., None], kb * jnp.exp(G)[..., None]], axis=-1)
    sol = lax.linalg.triangular_solve(tri, rhs, left_side=True, lower=True, unit_diagonal=True)
    u, w = sol[..., :Dv], sol[..., Dv:]
    qk = jnp.einsum('bhnid,bhnjd->bhnij', q, k) * gamma
    qg = q * jnp.exp(G)[..., None]
    kd = k * jnp.exp(G[..., -1:] - G)[..., None]
    dc = jnp.exp(G[..., -1])

    def step(state, xs):
        u_c, w_c, qk_c, qg_c, kd_c, dc_c = xs
        v_new = u_c - jnp.einsum('bhcd,bhde->bhce', w_c, state)
        o_c = jnp.einsum('bhcd,bhde->bhce', qg_c, state) + jnp.einsum('bhij,bhje->bhie', qk_c, v_new)
        state = state * dc_c[..., None, None] + jnp.einsum('bhcd,bhce->bhde', kd_c, v_new)
        return state, o_c

    xs = tuple(jnp.moveaxis(t, 2, 0) for t in (u, w, qk, qg, kd, dc))
    state0 = jnp.zeros((B, H, Dk, Dv), f32)
    _, o = lax.scan(step, state0, xs)
    return o.transpose(1, 0, 3, 2, 4).reshape(B, S, H, Dv)


def _causal_window_attention(q, k, v, span):
    N, L, H, Dh = q.shape
    nb = -(-L // ATTN_BLOCK)
    pad = nb * ATTN_BLOCK - L
    qb = jnp.pad(q, ((0, 0), (0, pad), (0, 0), (0, 0))).reshape(N, nb, ATTN_BLOCK, H, Dh)

    def kv_blocks(t):
        t = jnp.pad(t, ((0, 0), (ATTN_BLOCK, pad), (0, 0), (0, 0))).reshape(N, nb + 1, ATTN_BLOCK, H, Dh)
        return jnp.concatenate([t[:, :-1], t[:, 1:]], axis=2)

    kw, vw = kv_blocks(k), kv_blocks(v)
    s = jnp.einsum('nbqhd,nbkhd->nbhqk', qb, kw, preferred_element_type=jnp.float32)
    qi = jnp.arange(ATTN_BLOCK)[:, None]
    ki = jnp.arange(2 * ATTN_BLOCK)[None, :]
    dist = qi + ATTN_BLOCK - ki
    key_pos = jnp.arange(nb)[:, None, None] * ATTN_BLOCK - ATTN_BLOCK + ki[None]
    valid = (dist >= 0) & (dist <= span) & (key_pos >= 0)
    s = jnp.where(valid[None, :, None], s, -jnp.inf)
    lse = jax.nn.logsumexp(s, axis=-1)
    p = jnp.exp(s - lse[..., None])
    o = jnp.einsum('nbhqk,nbkhd->nbqhd', p, vw.astype(jnp.float32))
    o = o.reshape(N, nb * ATTN_BLOCK, H, Dh)[:, :L]
    lse = lse.transpose(0, 1, 3, 2).reshape(N, nb * ATTN_BLOCK, H)[:, :L]
    return o, lse


def _dilated_attention(q, k, v):
    B, S, H, Dh = q.shape
    q = q * (Dh ** -0.5)
    outs, lses = [], []
    for window, dil in DILATED_CONFIGS:
        L = S // dil

        def by_residue(t):
            return t.reshape(B, L, dil, H, Dh).transpose(0, 2, 1, 3, 4).reshape(B * dil, L, H, Dh)

        o, lse = _causal_window_attention(by_residue(q), by_residue(k), by_residue(v), window // dil)
        outs.append(o.reshape(B, dil, L, H, Dh).transpose(0, 2, 1, 3, 4).reshape(B, S, H, Dh))
        lses.append(lse.reshape(B, dil, L, H).transpose(0, 2, 1, 3).reshape(B, S, H))
    wts = jax.nn.softmax(jnp.stack(lses), axis=0)
    o = jnp.einsum('gbsh,gbshd->bshd', wts, jnp.stack(outs))
    return o.astype(v.dtype)


def _hybrid_mixer(h, cos, sin, w_in, dn_conv, dn_a_log, dn_dt_bias, dn_out_norm, w_out):
    B, S, _ = h.shape
    proj = h @ w_in
    a_qkv, a_z, a_b, a_a, b_q, b_k, b_v = jnp.split(proj, np.cumsum(IN_SPLITS)[:-1], axis=-1)
    a_qkv = jax.nn.silu(_causal_dwconv(a_qkv, dn_conv))
    aq, ak, av = jnp.split(a_qkv, 3, axis=-1)
    heads_a = lambda t: t.reshape(B, S, DN_HEADS, DN_HEAD_DIM)
    aq, ak, av = _l2norm(heads_a(aq)), _l2norm(heads_a(ak)), heads_a(av)
    beta = jax.nn.sigmoid(a_b.astype(jnp.float32))
    g = -jnp.exp(dn_a_log.astype(jnp.float32)) * jax.nn.softplus(a_a.astype(jnp.float32) + dn_dt_bias.astype(jnp.float32))
    o_a = _gated_delta_rule(aq, ak, av, g, beta).astype(h.dtype)
    o_a = _rmsnorm(o_a, dn_out_norm) * jax.nn.silu(heads_a(a_z))
    heads_b = lambda t: t.reshape(B, S, SWA_HEADS, SWA_HEAD_DIM)
    bq = _partial_rope(heads_b(b_q), cos, sin)
    bk = _partial_rope(heads_b(b_k), cos, sin)
    o_b = _dilated_attention(bq, bk, heads_b(b_v))
    mixed = jnp.concatenate([o_a.reshape(B, S, DN_WIDTH), o_b.reshape(B, S, SWA_WIDTH)], axis=-1)
    return mixed @ w_out


def _conv_glu_ffn(h, ffn_up, ffn_conv, ffn_conv_bias, ffn_down):
    u = _causal_dwconv(h @ ffn_up, ffn_conv) + ffn_conv_bias
    gate, val = jnp.split(u, 2, axis=-1)
    return (jax.nn.gelu(gate, approximate=True) * val) @ ffn_down


def setup_inputs(seed: int = 0) -> dict:
    key = jax.random.key(seed)
    ks = jax.random.split(key, 16)
    f32 = jnp.float32

    def normal(k, shape, scale):
        return jax.random.normal(k, shape, f32) * scale

    def gain(k, shape):
        return 1.0 + 0.02 * jax.random.normal(k, shape, f32)

    x = normal(ks[0], (BATCH, SEQ, D_MODEL), 1.0)
    pre_mix_norm = gain(ks[1], (DEPTH, D_MODEL))
    w_in = normal(ks[2], (DEPTH, D_MODEL, IN_WIDTH), D_MODEL ** -0.5)
    dn_conv = normal(ks[3], (DEPTH, DN_CONV, 3 * DN_WIDTH), DN_CONV ** -0.5)
    dn_a_log = jnp.log(jax.random.uniform(ks[4], (DEPTH, DN_HEADS), f32, 1.0, 16.0))
    dt = jnp.exp(jax.random.uniform(ks[5], (DEPTH, DN_HEADS), f32, math.log(1e-3), math.log(1e-1)))
    dn_dt_bias = dt + jnp.log(-jnp.expm1(-dt))
    dn_out_norm = gain(ks[6], (DEPTH, DN_HEAD_DIM))
    w_out = normal(ks[7], (DEPTH, D_MIX, D_MODEL), D_MIX ** -0.5)
    post_mix_norm = gain(ks[8], (DEPTH, D_MODEL))
    pre_ffn_norm = gain(ks[9], (DEPTH, D_MODEL))
    ffn_up = normal(ks[10], (DEPTH, D_MODEL, 2 * D_FF), D_MODEL ** -0.5)
    ffn_conv = normal(ks[11], (DEPTH, FFN_CONV, 2 * D_FF), FFN_CONV ** -0.5)
    ffn_conv_bias = normal(ks[12], (DEPTH, 2 * D_FF), 0.02)
    ffn_down = normal(ks[13], (DEPTH, D_FF, D_MODEL), D_FF ** -0.5)
    post_ffn_norm = gain(ks[14], (DEPTH, D_MODEL))
    return {"x": x, "pre_mix_norm": pre_mix_norm, "w_in": w_in, "dn_conv": dn_conv,
            "dn_a_log": dn_a_log, "dn_dt_bias": dn_dt_bias, "dn_out_norm": dn_out_norm,
            "w_out": w_out, "post_mix_norm": post_mix_norm, "pre_ffn_norm": pre_ffn_norm,
            "ffn_up": ffn_up, "ffn_conv": ffn_conv, "ffn_conv_bias": ffn_conv_bias,
            "ffn_down": ffn_down, "post_ffn_norm": post_ffn_norm}


def reference(x, pre_mix_norm, w_in, dn_conv, dn_a_log, dn_dt_bias, dn_out_norm, w_out,
              post_mix_norm, pre_ffn_norm, ffn_up, ffn_conv, ffn_conv_bias, ffn_down, post_ffn_norm):
    S = x.shape[1]
    cos, sin = _rope_tables(S)
    for l in range(DEPTH):
        h = _rmsnorm(x, pre_mix_norm[l])
        h = _hybrid_mixer(h, cos, sin, w_in[l], dn_conv[l], dn_a_log[l], dn_dt_bias[l], dn_out_norm[l], w_out[l])
        x = x + _rmsnorm(h, post_mix_norm[l])
        h = _rmsnorm(x, pre_ffn_norm[l])
        h = _conv_glu_ffn(h, ffn_up[l], ffn_conv[l], ffn_conv_bias[l], ffn_down[l])
        x = x + _rmsnorm(h, post_ffn_norm[l])
    return x
```

```cpp
#include <hip/hip_runtime.h>
#include <hip/hip_cooperative_groups.h>
#include <cstdio>
#include <cstdint>
namespace cg = cooperative_groups;

namespace pg8 {
#define PG8_LAS __attribute__((address_space(3)))
typedef unsigned short bf16_t;
typedef short bf16x8 __attribute__((ext_vector_type(8)));
typedef float f32x4 __attribute__((ext_vector_type(4)));
typedef unsigned u32x4 __attribute__((ext_vector_type(4)));
constexpr int BM = 256, BK = 64, HALF = 128, HTB = HALF * BK * 2  , STAGE_BYTES = 8 * HTB, NXCD = 8, WGM = 8;

__host__ __device__ __forceinline__ int lds_byte(int r, int c) { const int st = (r >> 4) * 2 + (c >> 5), rr = r & 15, cc = c & 31, ob = rr * 64 + cc * 2; return st * 1024 + (ob ^ (((ob >> 9) & 1) << 5)); }
__host__ __device__ __forceinline__ void stage_rc(int b, int& R, int& C) { const int st = b / 1024, sb = b % 1024, swz = sb ^ (((sb >> 9) & 1) << 5); R = (st >> 1) * 16 + swz / 64; C = (st & 1) * 32 + (swz % 64) / 2; }
__host__ __device__ __forceinline__ int perm32(int rho) { const int n = rho >> 4, i = rho & 15; return 8 * (i >> 2) + 4 * n + (i & 3); }

struct Unit { int pm, pn; };
struct Gemm { const bf16_t* A; const bf16_t* Bt; int M, N, K; };

struct StaticOrder {
    int nM, nN, nwg, G, c;
    __host__ __device__ void init(int M, int N, int G_, int c_) { nM = M / BM; nN = N / BM; nwg = nM * nN; G = G_; c = c_; }
    __host__ __device__ bool next(int i, Unit& u) const {
        const long L = (long)i * G + c; if (L >= nwg) return false;
        int wgid = (int)L; { const int q = nwg / NXCD, r = nwg % NXCD, xcd = wgid % NXCD, off = wgid / NXCD; wgid = (xcd < r ? xcd * (q + 1) : r * (q + 1) + (xcd - r) * q) + off; }
        const int nig = WGM * nN, gid = wgid / nig, fm = gid * WGM, gsz = (nM - fm) < WGM ? (nM - fm) : WGM;
        u.pm = fm + ((wgid % nig) % gsz); u.pn = (wgid % nig) / gsz; return true;
    }
    __device__ __forceinline__ void a_ready(const Unit&) const {}
    __device__ __forceinline__ void done(const Unit&) const {}
};

__device__ __forceinline__ unsigned cvt_pk_bf16(float lo, float hi) { unsigned r; asm volatile("v_cvt_pk_bf16_f32 %0, %1, %2" : "=v"(r) : "v"(lo), "v"(hi)); return r; }

struct EpiBf16 {
    static constexpr bool PERM = true, AFTER_DRAIN = false;
    bf16_t* O0; int ld0; int c1; bf16_t* O1; int ld1; int c2; bf16_t* O2; int ld2;
    __device__ __forceinline__ void operator()(const f32x4 (&acc)[2][2][4][2], const Unit& u, int wr, int wc, int fr, int fq) const {
        const int row0 = u.pm * BM + wr * 64 + fr; int colt = u.pn * BM; bf16_t* base = O0; int ldc = ld0;
        if (colt >= c2) { base = O2; ldc = ld2; colt -= c2; } else if (colt >= c1) { base = O1; ldc = ld1; colt -= c1; }
        const int col0 = colt + wc * 32 + 8 * fq;
#pragma unroll
        for (int ai = 0; ai < 2; ++ai)
#pragma unroll
            for (int m = 0; m < 4; ++m) { bf16_t* rowp = base + (size_t)(row0 + ai * HALF + m * 16) * ldc + col0;
#pragma unroll
                for (int bj = 0; bj < 2; ++bj) { const f32x4 v0 = acc[ai][bj][m][0], v1 = acc[ai][bj][m][1];
                    u32x4 w; w.x = cvt_pk_bf16(v0[0], v0[1]); w.y = cvt_pk_bf16(v0[2], v0[3]); w.z = cvt_pk_bf16(v1[0], v1[1]); w.w = cvt_pk_bf16(v1[2], v1[3]);
                    *(u32x4*)(rowp + bj * HALF) = w; } }
    }
};
struct EpiAny {
    static constexpr bool PERM = true, AFTER_DRAIN = false;
    unsigned char* ws; int k; const float* cw; const float* cb;
    __device__ __forceinline__ void operator()(const f32x4 (&acc)[2][2][4][2], const Unit& u, int wr, int wc, int fr, int fq) const {
        const int row0 = u.pm * BM + wr * 64 + fr; int colt = u.pn * BM;
        if (k == 5) {
            bf16_t* act = (bf16_t*)(ws + ((size_t)96 << 20)); bf16_t* halo = (bf16_t*)(ws + ((size_t)440 << 20));
            const int ch0 = u.pn * 128 + wc * 32 + 8 * fq;
#define ROR1(x) __builtin_bit_cast(float, __builtin_amdgcn_update_dpp(0, __builtin_bit_cast(int, (x)), 0x121, 0xf, 0xf, false))
#define ROR2(x) __builtin_bit_cast(float, __builtin_amdgcn_update_dpp(0, __builtin_bit_cast(int, (x)), 0x122, 0xf, 0xf, false))
#pragma unroll
            for (int n = 0; n < 2; ++n) {
                float wg[3][4], wv[3][4], bg[4], bv[4];
#pragma unroll
                for (int e = 0; e < 4; ++e) { const int c = ch0 + 4 * n + e;
#pragma unroll
                    for (int j = 0; j < 3; ++j) { wg[j][e] = cw[j * 5632 + c]; wv[j][e] = cw[j * 5632 + 2816 + c]; }
                    bg[e] = cb[c]; bv[e] = cb[2816 + c]; }
#pragma unroll
                for (int ai = 0; ai < 2; ++ai) {
                    const int strip = u.pm * 4 + ai * 2 + wr;
#pragma unroll
                    for (int m = 0; m < 4; ++m) {
                        const f32x4 gq = acc[ai][0][m][n], vq = acc[ai][1][m][n]; float o[4];
                        const f32x4 gp = m ? acc[ai][0][m ? m - 1 : 0][n] : (f32x4){0.f, 0.f, 0.f, 0.f}, vp = m ? acc[ai][1][m ? m - 1 : 0][n] : (f32x4){0.f, 0.f, 0.f, 0.f};
#pragma unroll
                        for (int e = 0; e < 4; ++e) {
                            const float g = gq[e], v = vq[e];
                            const float sg1 = fr == 15 ? gp[e] : g, sg2 = fr >= 14 ? gp[e] : g, sv1 = fr == 15 ? vp[e] : v, sv2 = fr >= 14 ? vp[e] : v;
                            const float a1g = ROR1(sg1), a2g = ROR2(sg2), a1v = ROR1(sv1), a2v = ROR2(sv2);
                            const float gc = wg[0][e] * a2g + wg[1][e] * a1g + wg[2][e] * g + bg[e];
                            const float vc = wv[0][e] * a2v + wv[1][e] * a1v + wv[2][e] * v + bv[e];
                            const float z = 0.7978845608028654f * (gc + 0.044715f * gc * gc * gc);
                            o[e] = gc * __builtin_amdgcn_rcpf(1.f + __expf(-2.f * z)) * vc;
                        }
                        typedef unsigned u32x2 __attribute__((ext_vector_type(2)));
                        u32x2 w; w.x = cvt_pk_bf16(o[0], o[1]); w.y = cvt_pk_bf16(o[2], o[3]);
                        *(u32x2*)(act + (size_t)(row0 + ai * HALF + m * 16) * 2816 + ch0 + 4 * n) = w;
                        if ((m == 0 && fr < 2) || (m == 3 && fr >= 14)) {
                            const int slot = (m == 0) ? fr : fr - 12;
                            bf16_t* hp = halo + ((size_t)strip * 4 + slot) * 5632 + u.pn * 256 + wc * 32 + 8 * fq + 4 * n;
                            u32x2 hg, hv; hg.x = cvt_pk_bf16(gq[0], gq[1]); hg.y = cvt_pk_bf16(gq[2], gq[3]); hv.x = cvt_pk_bf16(vq[0], vq[1]); hv.y = cvt_pk_bf16(vq[2], vq[3]);
                            *(u32x2*)hp = hg; *(u32x2*)(hp + 128) = hv;
                        }
                    }
                }
            }
#undef ROR1
#undef ROR2
        } else {
            bf16_t* base; int ldc;
            if (k == 0) { if (colt >= 2048) { base = (bf16_t*)(ws + ((size_t)128 << 20)); ldc = 1536; colt -= 2048; } else if (colt >= 1536) { base = (bf16_t*)(ws + ((size_t)96 << 20)); ldc = 512; colt -= 1536; }
                          else { base = (bf16_t*)(ws + ((size_t)224 << 20)); ldc = 1536; } }
            else if (k == 3) { base = (bf16_t*)(ws + ((size_t)96 << 20)); ldc = 1024; }
            else if (k == 9) { base = (bf16_t*)(ws + ((size_t)272 << 20)); ldc = 1024; }
            else { base = (bf16_t*)(ws + ((size_t)272 << 20)); ldc = (k == 5) ? 3072 : 2560; }
            const int col0 = colt + wc * 32 + 8 * fq;
#pragma unroll
            for (int ai = 0; ai < 2; ++ai)
#pragma unroll
                for (int m = 0; m < 4; ++m) { bf16_t* rowp = base + (size_t)(row0 + ai * HALF + m * 16) * ldc + col0;
#pragma unroll
                    for (int bj = 0; bj < 2; ++bj) { const f32x4 v0 = acc[ai][bj][m][0], v1 = acc[ai][bj][m][1];
                        u32x4 w; w.x = cvt_pk_bf16(v0[0], v0[1]); w.y = cvt_pk_bf16(v0[2], v0[3]); w.z = cvt_pk_bf16(v1[0], v1[1]); w.w = cvt_pk_bf16(v1[2], v1[3]);
                        *(u32x4*)(rowp + bj * HALF) = w; } }
        }
    }
};
struct EpiF32 {
    static constexpr bool PERM = true, AFTER_DRAIN = false;
    float* O; int ldc;
    __device__ __forceinline__ void operator()(const f32x4 (&acc)[2][2][4][2], const Unit& u, int wr, int wc, int fr, int fq) const {
        const int row0 = u.pm * BM + wr * 64 + fr; const int col0 = u.pn * BM + wc * 32 + 8 * fq;
#pragma unroll
        for (int ai = 0; ai < 2; ++ai)
#pragma unroll
            for (int m = 0; m < 4; ++m) { float* rowp = O + (size_t)(row0 + ai * HALF + m * 16) * ldc + col0;
#pragma unroll
                for (int bj = 0; bj < 2; ++bj) { *(f32x4*)(rowp + bj * HALF) = acc[ai][bj][m][0]; *(f32x4*)(rowp + bj * HALF + 4) = acc[ai][bj][m][1]; } }
    }
};

template <class Epi, class Sched, bool ALIGN_EPI = false, bool SP2 = false>
__device__ __forceinline__ void gemm_phase(PG8_LAS unsigned char* lds, const Gemm g, const Sched& S, const Epi& E, const int tid) {
    const int wid = __builtin_amdgcn_readfirstlane(tid >> 6), lane = tid & 63, wr = wid >> 2, wc = wid & 3, fr = lane & 15, fq = lane >> 4;
    const int K = g.K, nt = K / BK;
    unsigned voffA[2], voffB[2];
#pragma unroll
    for (int i = 0; i < 2; ++i) { int R, C; stage_rc(tid * 16 + i * 8192, R, C); const int Rb = Epi::PERM ? ((R & ~31) + perm32(R & 31)) : R;
        voffA[i] = (unsigned)(R * K + C) * 2u; voffB[i] = (unsigned)(Rb * K + C) * 2u; }
    const size_t kstep = (size_t)(BK * 2);
    const size_t hstep = (size_t)HALF * K * 2;
    const size_t tstep = 2 * hstep;
    const unsigned ldsw = (unsigned)wid * 1024u;
    const int aoff = lds_byte(wr * 64 + fr, fq * 8), boff = lds_byte(wc * 32 + fr, fq * 8);
#define PG8_SA(b, h) (((b) * 2 + (h)) * HTB)
#define PG8_SB(b, h) ((4 + (b) * 2 + (h)) * HTB)
#define PG8_STAGE(bufoff, gbase, voff) do { _Pragma("unroll") for (int _i = 0; _i < 2; ++_i) \
        __builtin_amdgcn_global_load_lds((const unsigned*)((const char*)(gbase) + (voff)[_i]), (PG8_LAS unsigned*)(lds + (bufoff) + ldsw + _i * 8192), 16, 0, 0); } while (0)
#define PG8_LDA(dst, b, h) do { _Pragma("unroll") for (int m = 0; m < 4; ++m) _Pragma("unroll") for (int k = 0; k < 2; ++k) dst[m][k] = *(const PG8_LAS bf16x8*)(lds + PG8_SA(b, h) + aoff + m * 2048 + k * 1024); } while (0)
#define PG8_LDB(dst, b, h) do { _Pragma("unroll") for (int n = 0; n < 2; ++n) _Pragma("unroll") for (int k = 0; k < 2; ++k) dst[n][k] = *(const PG8_LAS bf16x8*)(lds + PG8_SB(b, h) + boff + n * 2048 + k * 1024); } while (0)
#define PG8_MMA(ai, bj, At, Bt) do { __builtin_amdgcn_s_setprio(1); _Pragma("unroll") for (int m = 0; m < 4; ++m) _Pragma("unroll") for (int n = 0; n < 2; ++n) _Pragma("unroll") for (int k = 0; k < 2; ++k) \
        acc[ai][bj][m][n] = __builtin_amdgcn_mfma_f32_16x16x32_bf16(Bt[n][k], At[m][k], acc[ai][bj][m][n], 0, 0, 0); __builtin_amdgcn_s_setprio(0); } while (0)
#define PG8_WAIT_V(n) asm volatile("s_waitcnt vmcnt(" #n ")" ::: "memory")
#define PG8_WAIT_L(n) asm volatile("s_waitcnt lgkmcnt(" #n ")" ::: "memory")
#define PG8_BAR __builtin_amdgcn_s_barrier()
#define PG8_SCHED __builtin_amdgcn_sched_barrier(0)
    Unit cur, nxt; int ui = 0;
    if (!S.next(0, cur)) return;
    f32x4 acc[2][2][4][2];
#pragma unroll
    for (int a = 0; a < 2; ++a)
#pragma unroll
        for (int b = 0; b < 2; ++b)
#pragma unroll
            for (int m = 0; m < 4; ++m)
#pragma unroll
                for (int n = 0; n < 2; ++n) acc[a][b][m][n] = (f32x4){0.f, 0.f, 0.f, 0.f};
    bf16x8 At[4][2], B0[2][2], B1[2][2];
    const char* cA = (const char*)g.A + (size_t)cur.pm * tstep; const char* cB = (const char*)g.Bt + (size_t)cur.pn * tstep;
    S.a_ready(cur);
    if constexpr (SP2) {
        PG8_STAGE(PG8_SB(0, 0), cB, voffB); PG8_STAGE(PG8_SB(0, 1), cB + hstep, voffB); PG8_STAGE(PG8_SA(0, 0), cA, voffA); PG8_STAGE(PG8_SA(0, 1), cA + hstep, voffA);
        if (wr == 1) PG8_BAR;
        PG8_WAIT_V(2); PG8_BAR;
        PG8_STAGE(PG8_SB(1, 0), cB + kstep, voffB); PG8_STAGE(PG8_SA(1, 0), cA + kstep, voffA); PG8_STAGE(PG8_SB(1, 1), cB + hstep + kstep, voffB);
        PG8_WAIT_V(6); PG8_BAR;
    } else {
        PG8_STAGE(PG8_SB(0, 0), cB, voffB); PG8_STAGE(PG8_SA(0, 0), cA, voffA); PG8_STAGE(PG8_SB(0, 1), cB + hstep, voffB); PG8_STAGE(PG8_SA(0, 1), cA + hstep, voffA);
        if (wr == 1) PG8_BAR;
        PG8_WAIT_V(4); PG8_BAR;
        PG8_STAGE(PG8_SB(1, 0), cB + kstep, voffB); PG8_STAGE(PG8_SA(1, 0), cA + kstep, voffA); PG8_STAGE(PG8_SB(1, 1), cB + hstep + kstep, voffB);
        PG8_WAIT_V(6); PG8_BAR;
    }
    for (;;) {
        const bool has_next = S.next(ui + 1, nxt);
        const char* nA = has_next ? (const char*)g.A + (size_t)nxt.pm * tstep : cA; const char* nB = has_next ? (const char*)g.Bt + (size_t)nxt.pn * tstep : cB;
        for (int t = 0; t < nt; t += 2) {
            const bool last = (t == nt - 2);
            const char* a1 = cA + (size_t)(t + 1) * kstep;
            const char* a2 = last ? nA : cA + (size_t)(t + 2) * kstep; const char* b2 = last ? nB : cB + (size_t)(t + 2) * kstep;
            const char* a3 = a2 + kstep; const char* b3 = b2 + kstep;
            if (last && has_next) S.a_ready(nxt);
            if constexpr (SP2) {
            PG8_LDB(B0, 0, 0); PG8_LDB(B1, 0, 1); PG8_SCHED; PG8_LDA(At, 0, 0); PG8_STAGE(PG8_SA(1, 1), a1 + hstep, voffA);
            PG8_WAIT_V(8); PG8_WAIT_L(0); PG8_BAR; PG8_MMA(0, 0, At, B0); PG8_MMA(0, 1, At, B1); PG8_BAR; PG8_SCHED;
            PG8_LDA(At, 0, 1); PG8_STAGE(PG8_SB(0, 0), b2, voffB); PG8_STAGE(PG8_SB(0, 1), b2 + hstep, voffB); PG8_STAGE(PG8_SA(0, 0), a2, voffA);
            PG8_WAIT_V(8); PG8_WAIT_L(0); PG8_BAR; PG8_MMA(1, 0, At, B0); PG8_MMA(1, 1, At, B1); PG8_BAR; PG8_SCHED;
            PG8_LDB(B0, 1, 0); PG8_LDB(B1, 1, 1); PG8_SCHED; PG8_LDA(At, 1, 0); PG8_STAGE(PG8_SA(0, 1), a2 + hstep, voffA);
            PG8_WAIT_V(8); PG8_WAIT_L(0); PG8_BAR; PG8_MMA(0, 0, At, B0); PG8_MMA(0, 1, At, B1); PG8_BAR; PG8_SCHED;
            PG8_LDA(At, 1, 1); PG8_STAGE(PG8_SB(1, 0), b3, voffB); PG8_STAGE(PG8_SB(1, 1), b3 + hstep, voffB); PG8_STAGE(PG8_SA(1, 0), a3, voffA);
            PG8_WAIT_V(8); PG8_WAIT_L(0); PG8_BAR; PG8_MMA(1, 0, At, B0); PG8_MMA(1, 1, At, B1); PG8_BAR; PG8_SCHED;
            } else {
            PG8_LDB(B0, 0, 0); PG8_SCHED; PG8_LDA(At, 0, 0); PG8_STAGE(PG8_SA(1, 1), a1 + hstep, voffA);
            PG8_WAIT_L(8); PG8_BAR; PG8_WAIT_L(0); PG8_MMA(0, 0, At, B0); PG8_BAR; PG8_SCHED;
            PG8_LDB(B1, 0, 1); PG8_STAGE(PG8_SB(0, 0), b2, voffB);
            PG8_BAR; PG8_WAIT_L(0); PG8_MMA(0, 1, At, B1); PG8_BAR;
            PG8_LDA(At, 0, 1); PG8_STAGE(PG8_SA(0, 0), a2, voffA);
            PG8_BAR; PG8_WAIT_L(0); PG8_MMA(1, 0, At, B0); PG8_BAR; PG8_SCHED;
            PG8_STAGE(PG8_SB(0, 1), b2 + hstep, voffB);
            PG8_WAIT_V(6); PG8_BAR; PG8_MMA(1, 1, At, B1); PG8_BAR;
            PG8_LDB(B0, 1, 0); PG8_SCHED; PG8_LDA(At, 1, 0); PG8_STAGE(PG8_SA(0, 1), a2 + hstep, voffA);
            PG8_WAIT_L(8); PG8_BAR; PG8_WAIT_L(0); PG8_MMA(0, 0, At, B0); PG8_BAR; PG8_SCHED;
            PG8_LDB(B1, 1, 1); PG8_STAGE(PG8_SB(1, 0), b3, voffB);
            PG8_BAR; PG8_WAIT_L(0); PG8_MMA(0, 1, At, B1); PG8_BAR;
            PG8_LDA(At, 1, 1); PG8_STAGE(PG8_SA(1, 0), a3, voffA);
            PG8_BAR; PG8_WAIT_L(0); PG8_MMA(1, 0, At, B0); PG8_BAR; PG8_SCHED;
            PG8_STAGE(PG8_SB(1, 1), b3 + hstep, voffB);
            PG8_WAIT_V(6); PG8_BAR; PG8_MMA(1, 1, At, B1); PG8_BAR;
            }
        }
        if constexpr (ALIGN_EPI) { if (wr == 0) PG8_BAR; }
        if constexpr (!Epi::AFTER_DRAIN) { E(acc, cur, wr, wc, fr, fq); S.done(cur); }
        if (!has_next) break;
#pragma unroll
        for (int a = 0; a < 2; ++a)
#pragma unroll
            for (int b = 0; b < 2; ++b)
#pragma unroll
                for (int m = 0; m < 4; ++m)
#pragma unroll
                    for (int n = 0; n < 2; ++n) acc[a][b][m][n] = (f32x4){0.f, 0.f, 0.f, 0.f};
        cur = nxt; cA = nA; cB = nB; ++ui;
        if constexpr (ALIGN_EPI) { if (wr == 1) PG8_BAR; }
    }
    PG8_WAIT_V(0);
    if constexpr (!ALIGN_EPI) { if (wr == 0) PG8_BAR; }
    PG8_BAR;
    if constexpr (Epi::AFTER_DRAIN) { E.fused(acc, cur, wr, wc, fr, fq, lds, wid, lane); S.done(cur); }
#undef PG8_SA
#undef PG8_SB
#undef PG8_STAGE
#undef PG8_LDA
#undef PG8_LDB
#undef PG8_MMA
#undef PG8_WAIT_V
#undef PG8_WAIT_L
#undef PG8_BAR
#undef PG8_SCHED
}
}

#define LAS __attribute__((address_space(3)))
typedef unsigned short bf16;
typedef unsigned v4u __attribute__((ext_vector_type(4)));
typedef unsigned v2u __attribute__((ext_vector_type(2)));
typedef float f32x4 __attribute__((ext_vector_type(4)));
typedef short bf16x8 __attribute__((ext_vector_type(8)));
constexpr int NTHR = 512, NWAVES = 8;
constexpr int BATCH = 8, SEQ = 4096, M = BATCH * SEQ, D = 1024, DEPTH = 4;
constexpr int IN_W = 3592, NIN = 3584, DFF = 2816, DFF2 = 5632, HALF_FF = 1408;
constexpr float EPS = 1e-6f;
constexpr size_t MiB = 1u << 20;
constexpr size_t WS_WIN = 1 * MiB, WS_WOUT = 8 * MiB, WS_WUP = 10 * MiB, WS_WDOWN = 21 * MiB;
constexpr size_t WS_ROPE = 27 * MiB, WS_GATES = 28 * MiB;
constexpr size_t WS_XB = 32 * MiB;
constexpr size_t WS_Z = 96 * MiB, WS_BQKV = 128 * MiB, WS_AQKV = 224 * MiB, WS_QKVN = 320 * MiB;
constexpr size_t WS_Y = 96 * MiB;
constexpr size_t WS_ACT = 96 * MiB, WS_U = 272 * MiB, WS_Y2 = 272 * MiB;
constexpr size_t WS_NEED = 506 * MiB;
constexpr size_t WS_WODD = 479 * MiB;
constexpr int LDS_BYTES = 163840;
static_assert(WS_Y == (96u << 20) && WS_Y2 == (272u << 20) && WS_BQKV == (128u << 20) && WS_Z == (96u << 20) && WS_AQKV == (224u << 20) && WS_U == (272u << 20), "EpiAny hard-codes these offsets");

#define GAS __attribute__((address_space(1)))
struct Params {
    GAS const float* x; GAS const float* pre_mix_norm; GAS const float* w_in; GAS const float* dn_conv; GAS const float* dn_a_log; GAS const float* dn_dt_bias; GAS const float* dn_out_norm;
    GAS const float* w_out; GAS const float* post_mix_norm; GAS const float* pre_ffn_norm; GAS const float* ffn_up; GAS const float* ffn_conv; GAS const float* ffn_conv_bias;
    GAS const float* ffn_down; GAS const float* post_ffn_norm; GAS float* out; GAS unsigned char* ws;
};

typedef __attribute__((address_space(4))) const Params* CParams;
struct Ctx { int tid, bx; };
__device__ __forceinline__ unsigned f2bf(float f) { unsigned u = __float_as_uint(f); return (u + 0x7fffu + ((u >> 16) & 1u)) >> 16; }
typedef __bf16 bf16x2_t __attribute__((ext_vector_type(2)));
typedef float f32x2_t __attribute__((ext_vector_type(2)));
__device__ __forceinline__ unsigned cvtpk(float lo, float hi) { f32x2_t v = {lo, hi}; bf16x2_t b = __builtin_convertvector(v, bf16x2_t); return __builtin_bit_cast(unsigned, b); }
__device__ __forceinline__ unsigned pk2(float lo, float hi) { return cvtpk(lo, hi); }
__device__ __forceinline__ float bflo(unsigned u) { return __uint_as_float(u << 16); }
__device__ __forceinline__ float bfhi(unsigned u) { return __uint_as_float(u & 0xffff0000u); }
__device__ __forceinline__ float dpp_add(float v, const int ctrl_dummy) { return v; }
#define DPP_F(v, ctrl) __builtin_bit_cast(float, __builtin_amdgcn_update_dpp(0, __builtin_bit_cast(int, (v)), (ctrl), 0xf, 0xf, true))
__device__ __forceinline__ float wave_sum(float v) {
    v += DPP_F(v, 0xB1); v += DPP_F(v, 0x4E); v += DPP_F(v, 0x141); v += DPP_F(v, 0x140);
    const float r0 = __builtin_bit_cast(float, __builtin_amdgcn_readlane(__builtin_bit_cast(int, v), 0)), r1 = __builtin_bit_cast(float, __builtin_amdgcn_readlane(__builtin_bit_cast(int, v), 16));
    const float r2 = __builtin_bit_cast(float, __builtin_amdgcn_readlane(__builtin_bit_cast(int, v), 32)), r3 = __builtin_bit_cast(float, __builtin_amdgcn_readlane(__builtin_bit_cast(int, v), 48));
    return (r0 + r1) + (r2 + r3);
}
__device__ __forceinline__ float shflx(float v, int o, int lane) { return __builtin_bit_cast(float, __builtin_amdgcn_ds_bpermute((lane ^ o) << 2, __builtin_bit_cast(int, v))); }
__device__ __forceinline__ float silu_f(float y) { return y * __builtin_amdgcn_rcpf(1.f + __expf(-y)); }

__device__ __forceinline__ void transpose_item(const float* W, int ldw, int src_col0, int k0, bf16* WT, int K, int dst_row0, LAS float* scr, int lane) {
#pragma unroll 8
    for (int i = 0; i < 32; ++i) { const int kk = 2 * i + (lane >> 5); scr[kk * 33 + (lane & 31)] = W[(size_t)(k0 + kk) * ldw + src_col0 + (lane & 31)]; }
    asm volatile("s_waitcnt lgkmcnt(0)" ::: "memory");
    const int c = lane & 7;
#pragma unroll
    for (int j = 0; j < 4; ++j) { const int n = (lane >> 3) + 8 * j; const LAS float* s = scr + (8 * c) * 33 + n;
        v4u o; o.x = pk2(s[0 * 33], s[1 * 33]); o.y = pk2(s[2 * 33], s[3 * 33]); o.z = pk2(s[4 * 33], s[5 * 33]); o.w = pk2(s[6 * 33], s[7 * 33]);
        *(v4u*)(WT + (size_t)(dst_row0 + n) * K + k0 + 8 * c) = o; }
    asm volatile("s_waitcnt lgkmcnt(0)" ::: "memory");
}
__device__ __forceinline__ void convert_weights(CParams p, const Ctx cx, int l, int b0, LAS unsigned char* lds, int wave, int lane) {
    LAS float* scr = (LAS float*)(lds + 65536 + wave * 8448);
    const int gw = (cx.bx - b0) * NWAVES + wave, NGW = ((int)gridDim.x - b0) * NWAVES; const size_t wo = (l & 1) ? WS_WODD : 0;
    constexpr int I_IN = 16 * 112, I_OUT = 16 * 32, I_UP = 16 * 176, I_DN = 44 * 32;
    bf16* WinT = (bf16*)(((unsigned char*)p->ws) + WS_WIN + wo); bf16* WoutT = (bf16*)(((unsigned char*)p->ws) + WS_WOUT + wo); bf16* WupT = (bf16*)(((unsigned char*)p->ws) + WS_WUP + wo); bf16* WdnT = (bf16*)(((unsigned char*)p->ws) + WS_WDOWN + wo);
    for (int it = gw; it < I_IN + I_OUT + I_UP + I_DN; it += NGW) {
        int r = it;
        if (r < I_IN) { const int kb = r / 112, nb = r % 112, d0 = nb * 32, s0 = d0 < 2048 ? d0 : d0 + 8;
            transpose_item(((const float*)p->w_in) + (size_t)l * D * IN_W, IN_W, s0, kb * 64, WinT, D, d0, scr, lane); continue; } r -= I_IN;
        if (r < I_OUT) { const int kb = r / 32, nb = r % 32;
            transpose_item(((const float*)p->w_out) + (size_t)l * D * D, D, nb * 32, kb * 64, WoutT, D, nb * 32, scr, lane); continue; } r -= I_OUT;
        if (r < I_UP) { const int kb = r / 176, nb = r % 176, d0 = nb * 32, s0 = ((d0 & 255) >> 7) * DFF + (d0 >> 8) * 128 + (d0 & 127);
            transpose_item(((const float*)p->ffn_up) + (size_t)l * D * DFF2, DFF2, s0, kb * 64, WupT, D, d0, scr, lane); continue; } r -= I_UP;
        { const int kb = r / 32, nb = r % 32;
            transpose_item(((const float*)p->ffn_down) + (size_t)l * DFF * D, D, nb * 32, kb * 64, WdnT, DFF, nb * 32, scr, lane); }
    }
}
__device__ __forceinline__ void rope_table(CParams p, const Ctx cx) {
    float* tab = (float*)(((unsigned char*)p->ws) + WS_ROPE);
    const float invf[8] = {1.0f, 0.1939227432012558f, 0.03760603070259094f, 0.007292664609849453f, 0.0014142135623842478f, 0.00027424818836152554f, 5.3182957344688475e-05f, 1.0313385246263351e-05f};
    for (int i = cx.bx * NTHR + cx.tid; i < SEQ * 8; i += gridDim.x * NTHR) {
        const int pos = i >> 3, f = i & 7;
        float fr = invf[0];
#pragma unroll
        for (int q = 1; q < 8; ++q) fr = (f == q) ? invf[q] : fr;
        const float ang = (float)pos * fr;
        const double ad = (double)ang; const double n = __builtin_rint(ad * 0.15915494309189535); const float r = (float)(ad - n * 6.283185307179586);
        tab[pos * 16 + f] = cosf(r); tab[pos * 16 + 8 + f] = sinf(r);
    }
}

__device__ __forceinline__ void rowwise_phase(CParams p, const Ctx cx, const float* xsrc, const bf16* y, const float* wpost, const float* wpre, int gates_l, LAS unsigned char* lds, int wave, int lane) {
    LAS f32x4* gt = (LAS f32x4*)lds;
    if (gates_l >= 0) {
        const float* Wg = ((const float*)p->w_in) + (size_t)gates_l * D * IN_W + 2048;
        for (int i = cx.tid; i < 2048; i += NTHR) { const int ln = i & 63, half = (i >> 6) & 1, je = i >> 7, j = je >> 2, e = je & 3; const int k = 4 * ln + 256 * j + e;
            const float* s = Wg + (size_t)k * IN_W + 4 * half; gt[i] = (f32x4){s[0], s[1], s[2], s[3]}; }
        __syncthreads();
    }
    float* outp = ((float*)p->out); bf16* H = (bf16*)((float*)p->out); bf16* XB = (bf16*)(((unsigned char*)p->ws) + WS_XB); float* G = (float*)(((unsigned char*)p->ws) + WS_GATES);
    const int gw = cx.bx * NWAVES + wave, NGW = gridDim.x * NWAVES;
    f32x4 wpo[4], wpr[4];
#pragma unroll
    for (int j = 0; j < 4; ++j) { wpo[j] = wpost ? ((const f32x4*)wpost)[lane + 64 * j] : (f32x4){0.f, 0.f, 0.f, 0.f}; wpr[j] = wpre ? ((const f32x4*)wpre)[lane + 64 * j] : (f32x4){0.f, 0.f, 0.f, 0.f}; }
    constexpr int RB = 4;
    for (int rowb = gw; rowb < M; rowb += NGW * RB) {
        f32x4 xa[RB][4]; v2u ya[RB][4];
#pragma unroll
        for (int q = 0; q < RB; ++q) { const int row = rowb + q * NGW;
#pragma unroll
            for (int j = 0; j < 4; ++j) { if (xsrc) xa[q][j] = ((const f32x4*)(xsrc + (size_t)row * D))[lane + 64 * j]; else { const v2u xr = ((const v2u*)(XB + (size_t)row * D))[lane + 64 * j]; xa[q][j] = (f32x4){bflo(xr.x), bfhi(xr.x), bflo(xr.y), bfhi(xr.y)}; }
                if (y) ya[q][j] = ((const v2u*)(y + (size_t)row * D))[lane + 64 * j]; } }
#pragma unroll
        for (int q = 0; q < RB; ++q) {
        const int row = rowb + q * NGW;
        f32x4 xv[4];
#pragma unroll
        for (int j = 0; j < 4; ++j) xv[j] = xa[q][j];
        if (y) {
            f32x4 yv[4]; float s = 0.f;
#pragma unroll
            for (int j = 0; j < 4; ++j) { const v2u yr = ya[q][j]; yv[j] = (f32x4){bflo(yr.x), bfhi(yr.x), bflo(yr.y), bfhi(yr.y)}; s += (yv[j].x * yv[j].x + yv[j].y * yv[j].y) + (yv[j].z * yv[j].z + yv[j].w * yv[j].w); }
            const float ry = rsqrtf(wave_sum(s) * (1.f / D) + EPS);
#pragma unroll
            for (int j = 0; j < 4; ++j) xv[j] = xv[j] + yv[j] * ry * wpo[j];
        }
        if (wpre) {
#pragma unroll
            for (int j = 0; j < 4; ++j) { v2u o; o.x = pk2(xv[j].x, xv[j].y); o.y = pk2(xv[j].z, xv[j].w); ((v2u*)(XB + (size_t)row * D))[lane + 64 * j] = o; }
        } else {
#pragma unroll
            for (int j = 0; j < 4; ++j) ((f32x4*)(outp + (size_t)row * D))[lane + 64 * j] = xv[j];
        }
        if (wpre) {
            float s = 0.f;
#pragma unroll
            for (int j = 0; j < 4; ++j) s += (xv[j].x * xv[j].x + xv[j].y * xv[j].y) + (xv[j].z * xv[j].z + xv[j].w * xv[j].w);
            const float rx = rsqrtf(wave_sum(s) * (1.f / D) + EPS);
            f32x4 hv[4];
#pragma unroll
            for (int j = 0; j < 4; ++j) { hv[j] = xv[j] * rx * wpr[j];
                v2u o; o.x = pk2(hv[j].x, hv[j].y); o.y = pk2(hv[j].z, hv[j].w); ((v2u*)(H + (size_t)row * D))[lane + 64 * j] = o; }
            if (gates_l >= 0) {
                f32x4 a0 = {0.f, 0.f, 0.f, 0.f}, a1 = {0.f, 0.f, 0.f, 0.f};
#pragma unroll
                for (int j = 0; j < 4; ++j)
#pragma unroll
                    for (int e = 0; e < 4; ++e) { const float hh = hv[j][e]; const f32x4 w0 = gt[((j * 4 + e) * 2 + 0) * 64 + lane], w1 = gt[((j * 4 + e) * 2 + 1) * 64 + lane]; a0 = a0 + w0 * hh; a1 = a1 + w1 * hh; }
                float s0 = wave_sum(a0.x), s1 = wave_sum(a0.y), s2 = wave_sum(a0.z), s3 = wave_sum(a0.w), s4 = wave_sum(a1.x), s5 = wave_sum(a1.y), s6 = wave_sum(a1.z), s7 = wave_sum(a1.w);
                if (lane < 8) {
                    float v = s0; v = lane == 1 ? s1 : v; v = lane == 2 ? s2 : v; v = lane == 3 ? s3 : v; v = lane == 4 ? s4 : v; v = lane == 5 ? s5 : v; v = lane == 6 ? s6 : v; v = lane == 7 ? s7 : v;
                    float r;
                    if (lane < 4) r = 1.f / (1.f + __expf(-v));
                    else { const int hd = lane - 4; const float t = v + ((const float*)p->dn_dt_bias)[gates_l * 4 + hd]; const float sp = t > 15.f ? t : __logf(1.f + __expf(t)); r = -__expf(((const float*)p->dn_a_log)[gates_l * 4 + hd]) * sp; }
                    G[(size_t)row * 8 + lane] = r;
                }
            }
        }
        }
    }
}

__device__ __forceinline__ void d0_phase(CParams p, const Ctx cx, int l, int wave, int lane) {
    const bf16* A = (const bf16*)(((unsigned char*)p->ws) + WS_AQKV); bf16* Q = (bf16*)(((unsigned char*)p->ws) + WS_QKVN);
    const float* cw = ((const float*)p->dn_conv) + (size_t)l * 4 * 1536;
    const int gw = cx.bx * NWAVES + wave, NGW = gridDim.x * NWAVES;
    (void)gw; (void)NGW;
    for (int j = wave; j < 4 * ((BATCH * 4 * 64 - cx.bx + (int)gridDim.x - 1) / (int)gridDim.x); j += NWAVES) {
        const int un = cx.bx + (int)gridDim.x * (j >> 2), bh = un >> 6, h = bh & 3, m0 = (bh >> 2) * SEQ + (un & 63) * 64 + 16 * (j & 3), pos0 = m0 & (SEQ - 1);
        float w[3][4][2], win[3][3][2];
#pragma unroll
        for (int mt = 0; mt < 3; ++mt) { const int col = mt * 512 + h * 128 + 2 * lane;
#pragma unroll
            for (int j = 0; j < 4; ++j) { w[mt][j][0] = cw[j * 1536 + col]; w[mt][j][1] = cw[j * 1536 + col + 1]; }
#pragma unroll
            for (int k = 0; k < 3; ++k) {
                unsigned u = 0u; if (pos0 - 3 + k >= 0) u = *(const unsigned*)(A + (size_t)(m0 - 3 + k) * 1536 + col);
                win[mt][k][0] = bflo(u); win[mt][k][1] = bfhi(u); } }
        unsigned lu[16][3];
#pragma unroll
        for (int r = 0; r < 16; ++r)
#pragma unroll
            for (int mt = 0; mt < 3; ++mt) lu[r][mt] = *(const unsigned*)(A + (size_t)(m0 + r) * 1536 + mt * 512 + h * 128 + 2 * lane);
#pragma unroll
        for (int r = 0; r < 16; ++r) {
            const int m = m0 + r; float yv[3][2];
#pragma unroll
            for (int mt = 0; mt < 3; ++mt) { const unsigned u = lu[r][mt];
                const float c0 = bflo(u), c1 = bfhi(u);
                const float y0 = w[mt][0][0] * win[mt][0][0] + w[mt][1][0] * win[mt][1][0] + w[mt][2][0] * win[mt][2][0] + w[mt][3][0] * c0;
                const float y1 = w[mt][0][1] * win[mt][0][1] + w[mt][1][1] * win[mt][1][1] + w[mt][2][1] * win[mt][2][1] + w[mt][3][1] * c1;
                win[mt][0][0] = win[mt][1][0]; win[mt][0][1] = win[mt][1][1]; win[mt][1][0] = win[mt][2][0]; win[mt][1][1] = win[mt][2][1]; win[mt][2][0] = c0; win[mt][2][1] = c1;
                yv[mt][0] = silu_f(y0); yv[mt][1] = silu_f(y1); }
            const float sq = wave_sum(yv[0][0] * yv[0][0] + yv[0][1] * yv[0][1]), sk = wave_sum(yv[1][0] * yv[1][0] + yv[1][1] * yv[1][1]);
            const float rq = rsqrtf(sq + EPS) * 0.08838834764831845f, rk = rsqrtf(sk + EPS);
            bf16* o = Q + (size_t)m * 1536 + h * 128 + 2 * lane;
            *(unsigned*)(o) = pk2(yv[0][0] * rq, yv[0][1] * rq); *(unsigned*)(o + 512) = pk2(yv[1][0] * rk, yv[1][1] * rk); *(unsigned*)(o + 1024) = pk2(yv[2][0], yv[2][1]);
        }
    }
    bf16* Bq = (bf16*)(((unsigned char*)p->ws) + WS_BQKV); const float* tab = (const float*)(((unsigned char*)p->ws) + WS_ROPE);
    for (int i = cx.bx * NTHR + cx.tid; i < M * 16; i += gridDim.x * NTHR) {
        const int m = i >> 4, hh = i & 15, pos = m & (SEQ - 1);
        bf16* ptr = Bq + (size_t)m * 1536 + hh * 64;
        const v4u a = *(const v4u*)ptr, b = *(const v4u*)(ptr + 8);
        const f32x4 c0 = *(const f32x4*)(tab + pos * 16), c1 = *(const f32x4*)(tab + pos * 16 + 4), s0 = *(const f32x4*)(tab + pos * 16 + 8), s1 = *(const f32x4*)(tab + pos * 16 + 12);
        const float x1[8] = {bflo(a.x), bfhi(a.x), bflo(a.y), bfhi(a.y), bflo(a.z), bfhi(a.z), bflo(a.w), bfhi(a.w)};
        const float x2[8] = {bflo(b.x), bfhi(b.x), bflo(b.y), bfhi(b.y), bflo(b.z), bfhi(b.z), bflo(b.w), bfhi(b.w)};
        const float cc[8] = {c0.x, c0.y, c0.z, c0.w, c1.x, c1.y, c1.z, c1.w}, ss[8] = {s0.x, s0.y, s0.z, s0.w, s1.x, s1.y, s1.z, s1.w};
        float o1[8], o2[8];
#pragma unroll
        for (int q = 0; q < 8; ++q) { o1[q] = x1[q] * cc[q] - x2[q] * ss[q]; o2[q] = x2[q] * cc[q] + x1[q] * ss[q]; }
        v4u oa, ob; oa.x = pk2(o1[0], o1[1]); oa.y = pk2(o1[2], o1[3]); oa.z = pk2(o1[4], o1[5]); oa.w = pk2(o1[6], o1[7]);
        ob.x = pk2(o2[0], o2[1]); ob.y = pk2(o2[2], o2[3]); ob.z = pk2(o2[4], o2[5]); ob.w = pk2(o2[6], o2[7]);
        *(v4u*)ptr = oa; *(v4u*)(ptr + 8) = ob;
    }
}

__device__ __forceinline__ void scan_naive_unit(CParams p, const Ctx cx, int l, int bh, LAS unsigned char* lds, int wave, int lane) {
    const int b = bh >> 2, h = bh & 3, tid = cx.tid;
    const bf16* Q = (const bf16*)(((unsigned char*)p->ws) + WS_QKVN); const float* G = (const float*)(((unsigned char*)p->ws) + WS_GATES); const bf16* Z = (const bf16*)(((unsigned char*)p->ws) + WS_Z); bf16* MX = (bf16*)((float*)p->out);
    LAS float* obuf = (LAS float*)(lds + 49152); LAS float* gbeta = (LAS float*)(lds + 81920); LAS float* galpha = gbeta + 64;
    const int c16 = lane & 15, part = lane >> 4, c = 16 * wave + c16;
    float S[32];
#pragma unroll
    for (int i = 0; i < 32; ++i) S[i] = 0.f;
    for (int ch = 0; ch < SEQ / 64; ++ch) {
        const int mbase = b * SEQ + ch * 64;
        __syncthreads();
#pragma unroll
        for (int r = 0; r < 6; ++r) { const int idx = tid + NTHR * r, mat = idx >> 10, rem = idx & 1023, tk = rem >> 4, seg = rem & 15;
            const v4u v = *(const v4u*)(Q + (size_t)(mbase + tk) * 1536 + mat * 512 + h * 128 + seg * 8);
            *(LAS v4u*)(lds + mat * 16384 + tk * 256 + seg * 16) = v; }
        if (tid < 64) { gbeta[tid] = G[(size_t)(mbase + tid) * 8 + h]; galpha[tid] = __expf(G[(size_t)(mbase + tid) * 8 + 4 + h]); }
        __syncthreads();
        for (int tk = 0; tk < 64; ++tk) {
            const float beta = gbeta[tk], alpha = galpha[tk];
            float kf[32], acc = 0.f;
#pragma unroll
            for (int q4 = 0; q4 < 4; ++q4) { const v4u kv = *(const LAS v4u*)(lds + 16384 + tk * 256 + part * 64 + q4 * 16);
                kf[8 * q4 + 0] = bflo(kv.x); kf[8 * q4 + 1] = bfhi(kv.x); kf[8 * q4 + 2] = bflo(kv.y); kf[8 * q4 + 3] = bfhi(kv.y);
                kf[8 * q4 + 4] = bflo(kv.z); kf[8 * q4 + 5] = bfhi(kv.z); kf[8 * q4 + 6] = bflo(kv.w); kf[8 * q4 + 7] = bfhi(kv.w); }
#pragma unroll
            for (int i = 0; i < 32; ++i) acc += kf[i] * S[i];
            acc += shflx(acc, 16, lane); acc += shflx(acc, 32, lane);
            const unsigned short vb = *(const LAS unsigned short*)(lds + 32768 + tk * 256 + c * 2);
            const float vn = beta * (__uint_as_float((unsigned)vb << 16) - alpha * acc);
            float o = 0.f;
#pragma unroll
            for (int q4 = 0; q4 < 4; ++q4) { const v4u qv = *(const LAS v4u*)(lds + tk * 256 + part * 64 + q4 * 16);
                const float qf[8] = {bflo(qv.x), bfhi(qv.x), bflo(qv.y), bfhi(qv.y), bflo(qv.z), bfhi(qv.z), bflo(qv.w), bfhi(qv.w)};
#pragma unroll
                for (int e = 0; e < 8; ++e) { const int i = 8 * q4 + e; S[i] = alpha * S[i] + kf[i] * vn; o += qf[e] * S[i]; } }
            o += shflx(o, 16, lane); o += shflx(o, 32, lane);
            if (part == 0) obuf[tk * 128 + c] = o;
        }
        __syncthreads();
        {
            const int tk = tid >> 3, sub = tid & 7, m = mbase + tk;
            float ov[16], ss = 0.f;
#pragma unroll
            for (int q4 = 0; q4 < 4; ++q4) { const f32x4 t = *(const LAS f32x4*)(obuf + tk * 128 + sub * 16 + q4 * 4); ov[4 * q4] = t.x; ov[4 * q4 + 1] = t.y; ov[4 * q4 + 2] = t.z; ov[4 * q4 + 3] = t.w; }
#pragma unroll
            for (int e = 0; e < 16; ++e) ss += ov[e] * ov[e];
            ss += DPP_F(ss, 0xB1); ss += DPP_F(ss, 0x4E); ss += DPP_F(ss, 0x141);
            const float rstd = rsqrtf(ss * (1.f / 128.f) + EPS);
            const v4u z0 = *(const v4u*)(Z + (size_t)m * 512 + h * 128 + sub * 16), z1 = *(const v4u*)(Z + (size_t)m * 512 + h * 128 + sub * 16 + 8);
            const float zf[16] = {bflo(z0.x), bfhi(z0.x), bflo(z0.y), bfhi(z0.y), bflo(z0.z), bfhi(z0.z), bflo(z0.w), bfhi(z0.w), bflo(z1.x), bfhi(z1.x), bflo(z1.y), bfhi(z1.y), bflo(z1.z), bfhi(z1.z), bflo(z1.w), bfhi(z1.w)};
            const float* wn = ((const float*)p->dn_out_norm) + l * 128 + sub * 16;
            float r[16];
#pragma unroll
            for (int e = 0; e < 16; ++e) r[e] = ov[e] * rstd * wn[e] * silu_f(zf[e]);
            v4u o0, o1; o0.x = pk2(r[0], r[1]); o0.y = pk2(r[2], r[3]); o0.z = pk2(r[4], r[5]); o0.w = pk2(r[6], r[7]); o1.x = pk2(r[8], r[9]); o1.y = pk2(r[10], r[11]); o1.z = pk2(r[12], r[13]); o1.w = pk2(r[14], r[15]);
            bf16* dst = MX + (size_t)m * 1024 + h * 128 + sub * 16; *(v4u*)dst = o0; *(v4u*)(dst + 8) = o1;
        }
    }
}

__device__ __forceinline__ void attn_naive_item(CParams p, int item) {
    const int m = item >> 3, hd = item & 7, pos = m & (SEQ - 1);
    const bf16* Bq = (const bf16*)(((unsigned char*)p->ws) + WS_BQKV); bf16* MX = (bf16*)((float*)p->out);
    float q[64], acc[64];
    { const bf16* qp = Bq + (size_t)m * 1536 + hd * 64;
#pragma unroll
      for (int s = 0; s < 8; ++s) { const v4u v = *(const v4u*)(qp + 8 * s); q[8 * s] = bflo(v.x); q[8 * s + 1] = bfhi(v.x); q[8 * s + 2] = bflo(v.y); q[8 * s + 3] = bfhi(v.y); q[8 * s + 4] = bflo(v.z); q[8 * s + 5] = bfhi(v.z); q[8 * s + 6] = bflo(v.w); q[8 * s + 7] = bfhi(v.w); } }
#pragma unroll
    for (int i = 0; i < 64; ++i) acc[i] = 0.f;
    float mx = -1e30f, lsum = 0.f;
    for (int g = 0; g < 3; ++g) {
        const int d = g == 0 ? 1 : (g == 1 ? 4 : 16);
        for (int j = 0; j <= 128; ++j) {
            if (pos - j * d < 0) break;
            const bf16* kp = Bq + (size_t)(m - j * d) * 1536 + 512 + hd * 64; const bf16* vp = kp + 512;
            float s = 0.f;
#pragma unroll
            for (int t = 0; t < 8; ++t) { const v4u v = *(const v4u*)(kp + 8 * t);
                s += q[8 * t] * bflo(v.x) + q[8 * t + 1] * bfhi(v.x) + q[8 * t + 2] * bflo(v.y) + q[8 * t + 3] * bfhi(v.y) + q[8 * t + 4] * bflo(v.z) + q[8 * t + 5] * bfhi(v.z) + q[8 * t + 6] * bflo(v.w) + q[8 * t + 7] * bfhi(v.w); }
            s *= 0.125f;
            const float mn = fmaxf(mx, s), sc = __expf(mx - mn), pe = __expf(s - mn);
            lsum = lsum * sc + pe; mx = mn;
#pragma unroll
            for (int t = 0; t < 8; ++t) { const v4u v = *(const v4u*)(vp + 8 * t);
                acc[8 * t] = acc[8 * t] * sc + pe * bflo(v.x); acc[8 * t + 1] = acc[8 * t + 1] * sc + pe * bfhi(v.x); acc[8 * t + 2] = acc[8 * t + 2] * sc + pe * bflo(v.y); acc[8 * t + 3] = acc[8 * t + 3] * sc + pe * bfhi(v.y);
                acc[8 * t + 4] = acc[8 * t + 4] * sc + pe * bflo(v.z); acc[8 * t + 5] = acc[8 * t + 5] * sc + pe * bfhi(v.z); acc[8 * t + 6] = acc[8 * t + 6] * sc + pe * bflo(v.w); acc[8 * t + 7] = acc[8 * t + 7] * sc + pe * bfhi(v.w); }
        }
    }
    const float inv = 1.f / lsum; bf16* dst = MX + (size_t)m * 1024 + 512 + hd * 64;
#pragma unroll
    for (int s = 0; s < 8; ++s) { v4u o; o.x = pk2(acc[8 * s] * inv, acc[8 * s + 1] * inv); o.y = pk2(acc[8 * s + 2] * inv, acc[8 * s + 3] * inv); o.z = pk2(acc[8 * s + 4] * inv, acc[8 * s + 5] * inv); o.w = pk2(acc[8 * s + 6] * inv, acc[8 * s + 7] * inv); *(v4u*)(dst + 8 * s) = o; }
}


__device__ __forceinline__ unsigned pkhi(float lo, float hi) { return __builtin_amdgcn_perm(__float_as_uint(hi), __float_as_uint(lo), 0x07060302u); }
#define MFMA16(a, b, c) __builtin_amdgcn_mfma_f32_16x16x32_bf16((a), (b), (c), 0, 0, 0)
struct ATile { int tok0, dstep, C, valid; };
__device__ __forceinline__ ATile attn_tile(int u, int r, int T0, int fr) {
    int d, kt, roff, off, step, tb;
    if (u < 9) { d = 16; kt = u; roff = r; off = 0; step = 1; tb = T0 >> 4; }
    else if (u < 21) { d = 4; kt = u - 9; roff = r & 3; off = r >> 2; step = 4; tb = T0 >> 2; }
    else { d = 1; kt = u - 21; roff = 0; off = r; step = 16; tb = T0; }
    const int base = tb - 128 + 16 * kt;
    ATile t; t.valid = (base >= 0) && (u < 45); const int bb = t.valid ? base : 0;
    t.tok0 = roff + d * bb; t.dstep = d; t.C = off + step * fr + 128 - 16 * kt;
    return t;
}
struct APair { ATile t[2]; int dC; int act; };
__device__ __forceinline__ APair attn_pair(int pr, int w8, int T0, int fr) {
    APair q;
    if (pr < 5) { q.t[0] = attn_tile(2 * pr, w8, T0, fr); q.t[1] = attn_tile(2 * pr + 1 < 9 ? 2 * pr + 1 : 45, w8, T0, fr); q.dC = 0; q.act = 1; }
    else if (pr < 10) { const int k2 = 2 * (pr - 5); q.t[0] = attn_tile(k2, w8 + 8, T0, fr); q.t[1] = attn_tile(k2 + 1 < 9 ? k2 + 1 : 45, w8 + 8, T0, fr); q.dC = 0; q.act = 2; }
    else if (pr < 16) { const int k2 = 9 + 2 * (pr - 10); q.t[0] = attn_tile(k2, w8, T0, fr); q.t[1] = attn_tile(k2 + 1, w8, T0, fr); q.dC = 2; q.act = 3; }
    else { const int k2 = 21 + 2 * (pr - 16); q.t[0] = attn_tile(k2, w8, T0, fr); q.t[1] = attn_tile(k2 + 1, w8, T0, fr); q.dC = 8; q.act = 3; }
    return q;
}
__device__ __forceinline__ void attn_softmax_pv(const bf16x8 (&Kc)[2][2], const bf16x8 (&Qf)[2], const APair& pc, int dC, const bf16x8 (&Vt)[4], float& mrun, float& lrun, f32x4 (&O)[4], int fq, int lane) {
    const float SC = 0.125f * 1.4426950408889634f;
    f32x4 sc[2]; float pm = -3e30f;
#pragma unroll
    for (int h2 = 0; h2 < 2; ++h2) {
        f32x4 z = {0.f, 0.f, 0.f, 0.f};
        z = MFMA16(Kc[h2][0], Qf[0], z); z = MFMA16(Kc[h2][1], Qf[1], z);
        const int c4 = pc.t[h2].C + dC - 4 * fq;
#pragma unroll
        for (int j = 0; j < 4; ++j) { const bool ok = pc.t[h2].valid && ((unsigned)(c4 - j) <= 128u); z[j] = ok ? z[j] * SC : -3e30f; pm = fmaxf(pm, z[j]); }
        sc[h2] = z;
    }
    pm = fmaxf(pm, shflx(pm, 16, lane)); pm = fmaxf(pm, shflx(pm, 32, lane));
    const float mnew = fmaxf(mrun, pm), alpha = __builtin_amdgcn_exp2f(mrun - mnew); mrun = mnew;
    float ps = 0.f;
#pragma unroll
    for (int h2 = 0; h2 < 2; ++h2)
#pragma unroll
        for (int j = 0; j < 4; ++j) { sc[h2][j] = __builtin_amdgcn_exp2f(sc[h2][j] - mnew); ps += sc[h2][j]; }
    lrun = lrun * alpha + ps;
    v4u pp; pp.x = cvtpk(sc[0][0], sc[0][1]); pp.y = cvtpk(sc[0][2], sc[0][3]); pp.z = cvtpk(sc[1][0], sc[1][1]); pp.w = cvtpk(sc[1][2], sc[1][3]);
    const bf16x8 Pp = __builtin_bit_cast(bf16x8, pp);
#pragma unroll
    for (int mt = 0; mt < 4; ++mt) { O[mt] = O[mt] * alpha; O[mt] = MFMA16(Vt[mt], Pp, O[mt]); }
}
__device__ __forceinline__ void attn_mfma_unit(CParams p, int unit, int lane, LAS unsigned char* kvl) {
    const int w8 = unit & 7, I = unit >> 9, hd = (unit >> 3) & 7, b = (unit >> 6) & 7, T0 = I * 256, fr = lane & 15, fq = lane >> 4;
    const bf16* Bq = (const bf16*)(((unsigned char*)p->ws) + WS_BQKV); bf16* MX = (bf16*)((float*)p->out);
    const bf16* rowb = Bq + (size_t)b * SEQ * 1536 + hd * 64 + 8 * fq;
    const int qtokA = T0 + w8 + 16 * fr, qtokB = qtokA + 8;
    bf16x8 Qa[2], Qb[2];
    Qa[0] = *(const bf16x8*)(rowb + (size_t)qtokA * 1536); Qa[1] = *(const bf16x8*)(rowb + (size_t)qtokA * 1536 + 32);
    Qb[0] = *(const bf16x8*)(rowb + (size_t)qtokB * 1536); Qb[1] = *(const bf16x8*)(rowb + (size_t)qtokB * 1536 + 32);
    bf16x8 Sel[2];
#pragma unroll
    for (int c = 0; c < 2; ++c)
#pragma unroll
        for (int j = 0; j < 8; ++j) Sel[c][j] = (8 * fq + j == 16 * c + fr) ? (short)0x3F80 : (short)0;
    f32x4 Oa[4], Ob[4];
#pragma unroll
    for (int mt = 0; mt < 4; ++mt) { Oa[mt] = (f32x4){0.f, 0.f, 0.f, 0.f}; Ob[mt] = (f32x4){0.f, 0.f, 0.f, 0.f}; }
    float mA = -1e30f, lA = 0.f, mB = -1e30f, lB = 0.f;
    bf16x8 Kc[2][2], Vc[2][2], Kn[2][2], Vn[2][2];
    APair pc = attn_pair(0, w8, T0, fr), pn = pc;
#pragma unroll
    for (int h2 = 0; h2 < 2; ++h2) { const bf16* kp = rowb + (size_t)(pc.t[h2].tok0 + pc.t[h2].dstep * fr) * 1536 + 512;
        Kc[h2][0] = *(const bf16x8*)kp; Kc[h2][1] = *(const bf16x8*)(kp + 32); Vc[h2][0] = *(const bf16x8*)(kp + 512); Vc[h2][1] = *(const bf16x8*)(kp + 544); }
#pragma unroll 1
    for (int pr = 0; pr < 28; ++pr) {
        if (pr + 1 < 16) { pn = attn_pair(pr + 1, w8, T0, fr);
#pragma unroll
            for (int h2 = 0; h2 < 2; ++h2) { const bf16* kp = rowb + (size_t)(pn.t[h2].tok0 + pn.t[h2].dstep * fr) * 1536 + 512;
                Kn[h2][0] = *(const bf16x8*)kp; Kn[h2][1] = *(const bf16x8*)(kp + 32); Vn[h2][0] = *(const bf16x8*)(kp + 512); Vn[h2][1] = *(const bf16x8*)(kp + 544); }
        } else if (pr + 1 < 28) { pn = attn_pair(pr + 1, w8, T0, fr);
#pragma unroll
            for (int h2 = 0; h2 < 2; ++h2) { LAS unsigned char* kp = kvl + (16 * (2 * (pr + 1 - 16) + h2) + fr) * 272 + fq * 16;
                Kn[h2][0] = *(const LAS bf16x8*)kp; Kn[h2][1] = *(const LAS bf16x8*)(kp + 64); Vn[h2][0] = *(const LAS bf16x8*)(kp + 128); Vn[h2][1] = *(const LAS bf16x8*)(kp + 192); }
        }
        if (pc.t[0].valid | pc.t[1].valid) {
        bf16x8 Vt[4];
#pragma unroll
        for (int mt = 0; mt < 4; ++mt) {
            const f32x4 z = {0.f, 0.f, 0.f, 0.f};
            const f32x4 va = MFMA16(Vc[0][mt >> 1], Sel[mt & 1], z), vb = MFMA16(Vc[1][mt >> 1], Sel[mt & 1], z);
            v4u vp; vp.x = pkhi(va[0], va[1]); vp.y = pkhi(va[2], va[3]); vp.z = pkhi(vb[0], vb[1]); vp.w = pkhi(vb[2], vb[3]);
            Vt[mt] = __builtin_bit_cast(bf16x8, vp);
        }
        if (pc.act == 3) { attn_softmax_pv(Kc, Qa, pc, 0, Vt, mA, lA, Oa, fq, lane); attn_softmax_pv(Kc, Qb, pc, pc.dC, Vt, mB, lB, Ob, fq, lane); }
        else if (pc.act & 1) attn_softmax_pv(Kc, Qa, pc, 0, Vt, mA, lA, Oa, fq, lane);
        else attn_softmax_pv(Kc, Qb, pc, pc.dC, Vt, mB, lB, Ob, fq, lane);
        }
        pc = pn;
#pragma unroll
        for (int h2 = 0; h2 < 2; ++h2) { Kc[h2][0] = Kn[h2][0]; Kc[h2][1] = Kn[h2][1]; Vc[h2][0] = Vn[h2][0]; Vc[h2][1] = Vn[h2][1]; }
    }
    lA += shflx(lA, 16, lane); lA += shflx(lA, 32, lane); lB += shflx(lB, 16, lane); lB += shflx(lB, 32, lane);
    const float ia = 1.f / lA, ib = 1.f / lB;
    bf16* dA = MX + (size_t)(b * SEQ + qtokA) * 1024 + 512 + hd * 64 + 4 * fq; bf16* dB = dA + (size_t)8 * 1024;
#pragma unroll
    for (int mt = 0; mt < 4; ++mt) { v2u o; o.x = cvtpk(Oa[mt][0] * ia, Oa[mt][1] * ia); o.y = cvtpk(Oa[mt][2] * ia, Oa[mt][3] * ia); *(v2u*)(dA + 16 * mt) = o;
        v2u o2; o2.x = cvtpk(Ob[mt][0] * ib, Ob[mt][1] * ib); o2.y = cvtpk(Ob[mt][2] * ib, Ob[mt][3] * ib); *(v2u*)(dB + 16 * mt) = o2; }
}


__device__ __forceinline__ void attn_stage(CParams p, const Ctx cx, int bu, LAS unsigned char* kvl) {
    const int I = bu >> 6, hd = bu & 7, b = (bu >> 3) & 7, T0 = I * 256;
    const bf16* Bq = (const bf16*)(((unsigned char*)p->ws) + WS_BQKV) + (size_t)b * SEQ * 1536 + 512 + hd * 64;
    __syncthreads();
    v4u st[12];
#pragma unroll
    for (int r = 0; r < 12; ++r) { const int idx = cx.tid + NTHR * r, row = idx >> 4, seg = idx & 15, tok = T0 - 128 + row;
        st[r] = (v4u){0u, 0u, 0u, 0u};
        if (tok >= 0) st[r] = *(const v4u*)(Bq + (size_t)tok * 1536 + (seg < 8 ? seg * 8 : 512 + (seg - 8) * 8)); }
#pragma unroll
    for (int r = 0; r < 12; ++r) { const int idx = cx.tid + NTHR * r; *(LAS v4u*)(kvl + (idx >> 4) * 272 + (idx & 15) * 16) = st[r]; }
    __syncthreads();
}

constexpr size_t WS_UT = 224 * MiB, WS_WM = 256 * MiB, WS_KT = 288 * MiB, WS_QKM = 416 * MiB, WS_GC = 432 * MiB, WS_ORAW = 440 * MiB;
__device__ __forceinline__ void d1_unit(CParams p, const Ctx cx, int unit, LAS unsigned char* lds, int wave, int lane) {
    const int tid = cx.tid, c = unit & 63, bh = unit >> 6, b = bh >> 2, h = bh & 3, mbase = b * SEQ + c * 64, fr = lane & 15, fq = lane >> 4;
    const bf16* Q = (const bf16*)(((unsigned char*)p->ws) + WS_QKVN); const float* Gt = (const float*)(((unsigned char*)p->ws) + WS_GATES);
    LAS unsigned char* qs = lds; LAS unsigned char* ks = lds + 17408; LAS unsigned char* vs = lds + 34816;
    LAS float* Am = (LAS float*)(lds + 51200); LAS float* gG = (LAS float*)(lds + 67584); LAS float* gB = gG + 64; LAS float* gE = gG + 128;
    __syncthreads();
#pragma unroll
    for (int r = 0; r < 6; ++r) { const int idx = tid + NTHR * r, mat = idx >> 10, rem = idx & 1023, tk = rem >> 4, seg = rem & 15;
        const v4u v = *(const v4u*)(Q + (size_t)(mbase + tk) * 1536 + mat * 512 + h * 128 + seg * 8);
        *(LAS v4u*)(lds + (mat == 2 ? 34816 + tk * 256 : mat * 17408 + tk * 272) + seg * 16) = v; }
    if (tid < 64) {
        float g = Gt[(size_t)(mbase + tid) * 8 + 4 + h]; const float be = Gt[(size_t)(mbase + tid) * 8 + h];
#pragma unroll
        for (int o = 1; o < 64; o <<= 1) { const float t = shflx(g, 0, lane - o < 0 ? lane : lane - o); if (lane >= o) g += t; }
        const float glast = __builtin_bit_cast(float, __builtin_amdgcn_readlane(__builtin_bit_cast(int, g), 63));
        gG[tid] = g; gB[tid] = be; gE[tid] = __expf(g);
        float* gc = (float*)(((unsigned char*)p->ws) + WS_GC) + (size_t)unit * 128; gc[tid] = __expf(g); gc[64 + tid] = __expf(glast - g);
    }
    __syncthreads();
    {
        const int mat = wave >> 2, tm = wave & 3;
        LAS unsigned char* asrc = (mat ? qs : ks) + (16 * tm + fr) * 272 + fq * 16;
        bf16x8 af[4];
#pragma unroll
        for (int s4 = 0; s4 < 4; ++s4) af[s4] = *(const LAS bf16x8*)(asrc + s4 * 64);
        float Gi[4], Bi[4];
#pragma unroll
        for (int j = 0; j < 4; ++j) { Gi[j] = gG[16 * tm + 4 * fq + j]; Bi[j] = gB[16 * tm + 4 * fq + j]; }
#pragma unroll
        for (int tn = 0; tn < 4; ++tn) {
            f32x4 acc = {0.f, 0.f, 0.f, 0.f};
#pragma unroll
            for (int s4 = 0; s4 < 4; ++s4) { const bf16x8 bfr = *(const LAS bf16x8*)(ks + (16 * tn + fr) * 272 + fq * 16 + s4 * 64); acc = MFMA16(af[s4], bfr, acc); }
            const int jj = 16 * tn + fr; const float Gj = gG[jj];
#pragma unroll
            for (int j = 0; j < 4; ++j) { const int ii = 16 * tm + 4 * fq + j; const float e = __expf(fminf(Gi[j] - Gj, 0.f));
                if (mat == 0) Am[jj * 64 + ii] = (ii > jj) ? Bi[j] * acc[j] * e : 0.f;
                else *(LAS unsigned short*)(lds + 134144 + (ii * 64 + jj) * 2) = (unsigned short)f2bf((ii >= jj) ? acc[j] * e : 0.f); }
        }
    }
    __syncthreads();
    if (tid < 256) {
        const int cc = tid & 127; const bool isw = tid >= 128;
        LAS float* xs = (LAS float*)(lds + 68608);
#pragma unroll 1
        for (int blk = 0; blk < 4; ++blk) {
            float acc[16];
#pragma unroll
            for (int r = 0; r < 16; ++r) { const int i = 16 * blk + r;
                const unsigned short raw = isw ? *(const LAS unsigned short*)(ks + i * 272 + cc * 2) : *(const LAS unsigned short*)(vs + i * 256 + cc * 2);
                float a = __uint_as_float((unsigned)raw << 16) * gB[i]; if (isw) a *= gE[i]; acc[r] = a; }
#pragma unroll 4
            for (int j = 0; j < 16 * blk; ++j) { const float xj = xs[j * 256 + tid]; const LAS f32x4* at = (const LAS f32x4*)(Am + j * 64 + 16 * blk);
#pragma unroll
                for (int q = 0; q < 4; ++q) { const f32x4 t = at[q]; acc[4 * q] -= t.x * xj; acc[4 * q + 1] -= t.y * xj; acc[4 * q + 2] -= t.z * xj; acc[4 * q + 3] -= t.w * xj; } }
#pragma unroll
            for (int r2 = 0; r2 < 15; ++r2) { const float xr = acc[r2]; const LAS float* row = Am + (16 * blk + r2) * 64 + 16 * blk;
#pragma unroll
                for (int q = (r2 + 1) / 4; q < 4; ++q) { const f32x4 t = *(const LAS f32x4*)(row + 4 * q);
                    if (4 * q + 0 > r2) acc[4 * q + 0] -= t.x * xr; if (4 * q + 1 > r2) acc[4 * q + 1] -= t.y * xr; if (4 * q + 2 > r2) acc[4 * q + 2] -= t.z * xr; if (4 * q + 3 > r2) acc[4 * q + 3] -= t.w * xr; } }
#pragma unroll
            for (int r = 0; r < 16; ++r) xs[(16 * blk + r) * 256 + tid] = acc[r];
        }
    } else {
        const int t2 = tid - 256, dk = t2 & 127, g2 = t2 >> 7; bf16* kt = (bf16*)(((unsigned char*)p->ws) + WS_KT) + (size_t)unit * 8192 + dk * 64 + 32 * g2;
#pragma unroll
        for (int q8 = 0; q8 < 4; ++q8) { unsigned short e[8];
#pragma unroll
            for (int t = 0; t < 8; ++t) e[t] = *(const LAS unsigned short*)(ks + (32 * g2 + 8 * q8 + t) * 272 + dk * 2);
            v4u o; o.x = e[0] | ((unsigned)e[1] << 16); o.y = e[2] | ((unsigned)e[3] << 16); o.z = e[4] | ((unsigned)e[5] << 16); o.w = e[6] | ((unsigned)e[7] << 16); *(v4u*)(kt + 8 * q8) = o; }
    }
    __syncthreads();
    {
        const LAS float* xs = (const LAS float*)(lds + 68608);
        bf16* wm = (bf16*)(((unsigned char*)p->ws) + WS_WM) + (size_t)unit * 8192; bf16* ut = (bf16*)(((unsigned char*)p->ws) + WS_UT) + (size_t)unit * 8192;
#pragma unroll
        for (int r2 = 0; r2 < 2; ++r2) { const int idx = tid + NTHR * r2, i = idx >> 4, seg = idx & 15;
            const f32x4 a0 = *(const LAS f32x4*)(xs + i * 256 + 128 + seg * 8), a1 = *(const LAS f32x4*)(xs + i * 256 + 128 + seg * 8 + 4);
            v4u o; o.x = cvtpk(a0.x, a0.y); o.y = cvtpk(a0.z, a0.w); o.z = cvtpk(a1.x, a1.y); o.w = cvtpk(a1.z, a1.w); *(v4u*)(wm + i * 128 + seg * 8) = o; }
#pragma unroll
        for (int r2 = 0; r2 < 2; ++r2) { const int idx = tid + NTHR * r2, dv = idx >> 3, seg = idx & 7; float e[8];
#pragma unroll
            for (int t = 0; t < 8; ++t) e[t] = xs[(seg * 8 + t) * 256 + dv];
            v4u o; o.x = cvtpk(e[0], e[1]); o.y = cvtpk(e[2], e[3]); o.z = cvtpk(e[4], e[5]); o.w = cvtpk(e[6], e[7]); *(v4u*)(ut + dv * 64 + seg * 8) = o; }
        { const v4u q = *(const LAS v4u*)(lds + 134144 + tid * 16); *(v4u*)((bf16*)(((unsigned char*)p->ws) + WS_QKM) + (size_t)unit * 4096 + tid * 8) = q; }
    }
}

__device__ __forceinline__ bf16x8 ldfrag8(LAS unsigned char* pa) { const v2u a = *(const LAS v2u*)pa, b = *(const LAS v2u*)(pa + 32); v4u r; r.x = a.x; r.y = a.y; r.z = b.x; r.w = b.y; return __builtin_bit_cast(bf16x8, r); }
__device__ __forceinline__ void scan_chunked_unit(CParams p, const Ctx cx, int l, int bh, LAS unsigned char* lds, int wave, int lane) {
    const int tid = cx.tid, b = bh >> 2, h = bh & 3, fr = lane & 15, fq = lane >> 4;
    const bf16* Q = (const bf16*)(((unsigned char*)p->ws) + WS_QKVN); bf16* OR = (bf16*)(((unsigned char*)p->ws) + WS_ORAW);
    const bf16* Wm = (const bf16*)(((unsigned char*)p->ws) + WS_WM); const bf16* KT = (const bf16*)(((unsigned char*)p->ws) + WS_KT); const bf16* UT = (const bf16*)(((unsigned char*)p->ws) + WS_UT); const bf16* QKm = (const bf16*)(((unsigned char*)p->ws) + WS_QKM);
    const float* Gc = (const float*)(((unsigned char*)p->ws) + WS_GC);
    constexpr int BUF = 61440, O_W = 0, O_Q = 17408, O_KT = 34816, O_QK = 52224, O_G = 2 * BUF, O_OT = 2 * BUF + 1024;
    f32x4 Sacc[8];
#pragma unroll
    for (int dt = 0; dt < 8; ++dt) Sacc[dt] = (f32x4){0.f, 0.f, 0.f, 0.f};
    v4u st[7]; float gst = 0.f;
    __syncthreads();
#define SCAN_LOAD(ch) do { const size_t un = (size_t)bh * 64 + (ch); const int mb = b * SEQ + (ch) * 64; \
        _Pragma("unroll") for (int r = 0; r < 7; ++r) { const int idx = tid + NTHR * r; const bf16* src; \
            if (r < 2) src = Wm + un * 8192 + (idx >> 4) * 128 + (idx & 15) * 8; \
            else if (r < 4) src = Q + (size_t)(mb + ((idx - 1024) >> 4)) * 1536 + h * 128 + (idx & 15) * 8; \
            else if (r < 6) src = KT + un * 8192 + ((idx - 2048) >> 3) * 64 + (idx & 7) * 8; \
            else src = QKm + un * 4096 + ((idx - 3072) >> 3) * 64 + (idx & 7) * 8; \
            st[r] = *(const v4u*)src; } \
        if (tid < 128) gst = Gc[un * 128 + tid]; } while (0)
#define SCAN_STORE(par) do { LAS unsigned char* bb = lds + (par) * BUF; \
        _Pragma("unroll") for (int r = 0; r < 7; ++r) { const int idx = tid + NTHR * r; int off; \
            if (r < 2) off = O_W + (idx >> 4) * 272 + (idx & 15) * 16; \
            else if (r < 4) off = O_Q + ((idx - 1024) >> 4) * 272 + (idx & 15) * 16; \
            else if (r < 6) off = O_KT + ((idx - 2048) >> 3) * 136 + (idx & 7) * 16; \
            else off = O_QK + ((idx - 3072) >> 3) * 136 + (idx & 7) * 16; \
            *(LAS v4u*)(bb + off) = st[r]; } \
        if (tid < 128) ((LAS float*)(lds + O_G))[(par) * 128 + tid] = gst; } while (0)
    SCAN_LOAD(0); SCAN_STORE(0);
    v2u uun[4];
#pragma unroll
    for (int tm = 0; tm < 4; ++tm) uun[tm] = *(const v2u*)(UT + (size_t)bh * 64 * 8192 + (16 * wave + fr) * 64 + 16 * tm + 4 * fq);
    const int ftk = tid >> 3, fsub = tid & 7;
    __syncthreads();
    for (int ch = 0; ch < SEQ / 64; ++ch) {
        const int par = ch & 1, mb = b * SEQ + ch * 64; const size_t un = (size_t)bh * 64 + ch;
        LAS unsigned char* bb = lds + par * BUF;
        if (ch + 1 < SEQ / 64) SCAN_LOAD(ch + 1);
        v2u uu[4];
#pragma unroll
        for (int tm = 0; tm < 4; ++tm) uu[tm] = uun[tm];
        if (ch + 1 < SEQ / 64) {
#pragma unroll
            for (int tm = 0; tm < 4; ++tm) uun[tm] = *(const v2u*)(UT + (un + 1) * 8192 + (16 * wave + fr) * 64 + 16 * tm + 4 * fq);
        }
        const LAS float* Gs = (const LAS float*)(lds + O_G) + par * 128;
        const float dc = Gs[63];
        bf16x8 Sb[4];
#pragma unroll
        for (int s4 = 0; s4 < 4; ++s4) { v4u t; t.x = cvtpk(Sacc[2 * s4][0], Sacc[2 * s4][1]); t.y = cvtpk(Sacc[2 * s4][2], Sacc[2 * s4][3]); t.z = cvtpk(Sacc[2 * s4 + 1][0], Sacc[2 * s4 + 1][1]); t.w = cvtpk(Sacc[2 * s4 + 1][2], Sacc[2 * s4 + 1][3]); Sb[s4] = __builtin_bit_cast(bf16x8, t); }
        f32x4 VN[4], OO[4];
#pragma unroll
        for (int tm = 0; tm < 4; ++tm) {
            f32x4 ws_ = {0.f, 0.f, 0.f, 0.f}, qs_ = {0.f, 0.f, 0.f, 0.f};
#pragma unroll
            for (int s4 = 0; s4 < 4; ++s4) { ws_ = MFMA16(ldfrag8(bb + O_W + (16 * tm + fr) * 272 + 64 * s4 + 8 * fq), Sb[s4], ws_);
                                              qs_ = MFMA16(ldfrag8(bb + O_Q + (16 * tm + fr) * 272 + 64 * s4 + 8 * fq), Sb[s4], qs_); }
            const float u0 = bflo(uu[tm].x), u1 = bfhi(uu[tm].x), u2 = bflo(uu[tm].y), u3 = bfhi(uu[tm].y);
            VN[tm] = (f32x4){u0 - ws_[0], u1 - ws_[1], u2 - ws_[2], u3 - ws_[3]};
#pragma unroll
            for (int j = 0; j < 4; ++j) OO[tm][j] = qs_[j] * Gs[16 * tm + 4 * fq + j];
        }
        bf16x8 Vb[2], Vd[2];
#pragma unroll
        for (int s2 = 0; s2 < 2; ++s2) {
            v4u t; t.x = cvtpk(VN[2 * s2][0], VN[2 * s2][1]); t.y = cvtpk(VN[2 * s2][2], VN[2 * s2][3]); t.z = cvtpk(VN[2 * s2 + 1][0], VN[2 * s2 + 1][1]); t.w = cvtpk(VN[2 * s2 + 1][2], VN[2 * s2 + 1][3]); Vb[s2] = __builtin_bit_cast(bf16x8, t);
            float e[8];
#pragma unroll
            for (int j = 0; j < 8; ++j) e[j] = Gs[64 + 16 * (2 * s2 + (j >> 2)) + 4 * fq + (j & 3)];
            v4u d; d.x = cvtpk(VN[2 * s2][0] * e[0], VN[2 * s2][1] * e[1]); d.y = cvtpk(VN[2 * s2][2] * e[2], VN[2 * s2][3] * e[3]); d.z = cvtpk(VN[2 * s2 + 1][0] * e[4], VN[2 * s2 + 1][1] * e[5]); d.w = cvtpk(VN[2 * s2 + 1][2] * e[6], VN[2 * s2 + 1][3] * e[7]); Vd[s2] = __builtin_bit_cast(bf16x8, d);
        }
#pragma unroll
        for (int tm = 0; tm < 4; ++tm)
#pragma unroll
            for (int s2 = 0; s2 < 2; ++s2) OO[tm] = MFMA16(ldfrag8(bb + O_QK + (16 * tm + fr) * 136 + 64 * s2 + 8 * fq), Vb[s2], OO[tm]);
#pragma unroll
        for (int dt = 0; dt < 8; ++dt) { Sacc[dt] = Sacc[dt] * dc;
#pragma unroll
            for (int s2 = 0; s2 < 2; ++s2) Sacc[dt] = MFMA16(ldfrag8(bb + O_KT + (16 * dt + fr) * 136 + 64 * s2 + 8 * fq), Vd[s2], Sacc[dt]); }
        LAS float* Ot = (LAS float*)(lds + O_OT);
#pragma unroll
        for (int tm = 0; tm < 4; ++tm)
#pragma unroll
            for (int j = 0; j < 4; ++j) Ot[(16 * tm + 4 * fq + j) * 128 + 16 * wave + fr] = OO[tm][j];
        if (ch + 1 < SEQ / 64) SCAN_STORE(par ^ 1);
        __syncthreads();
        {
            float ov[16];
#pragma unroll
            for (int q4 = 0; q4 < 4; ++q4) { const f32x4 t = *(const LAS f32x4*)(Ot + ftk * 128 + fsub * 16 + q4 * 4); ov[4 * q4] = t.x; ov[4 * q4 + 1] = t.y; ov[4 * q4 + 2] = t.z; ov[4 * q4 + 3] = t.w; }
            v4u o0, o1; o0.x = cvtpk(ov[0], ov[1]); o0.y = cvtpk(ov[2], ov[3]); o0.z = cvtpk(ov[4], ov[5]); o0.w = cvtpk(ov[6], ov[7]); o1.x = cvtpk(ov[8], ov[9]); o1.y = cvtpk(ov[10], ov[11]); o1.z = cvtpk(ov[12], ov[13]); o1.w = cvtpk(ov[14], ov[15]);
            bf16* dst = OR + (size_t)(mb + ftk) * 512 + h * 128 + fsub * 16; *(v4u*)dst = o0; *(v4u*)(dst + 8) = o1;
        }
        __syncthreads();
    }
#undef SCAN_LOAD
#undef SCAN_STORE
}


__device__ __forceinline__ void gate_phase(CParams p, const Ctx cx, int l, int wave, int lane) {
    const bf16* OR = (const bf16*)(((unsigned char*)p->ws) + WS_ORAW); const bf16* Z = (const bf16*)(((unsigned char*)p->ws) + WS_Z); bf16* MX = (bf16*)((float*)p->out);
    const int gw = cx.bx * NWAVES + wave, NGW = gridDim.x * NWAVES, sub = lane & 15, rl = lane >> 4;
    float wn[8];
#pragma unroll
    for (int e = 0; e < 8; ++e) wn[e] = ((const float*)p->dn_out_norm)[l * 128 + 8 * sub + e];
    constexpr int RB = 4;
    for (int itb = gw; itb < M; itb += NGW * RB) {
        v4u oa[RB], za[RB];
#pragma unroll
        for (int q = 0; q < RB; ++q) { const size_t off = (size_t)(itb + q * NGW) * 512 + rl * 128 + 8 * sub; oa[q] = *(const v4u*)(OR + off); za[q] = *(const v4u*)(Z + off); }
#pragma unroll
        for (int q = 0; q < RB; ++q) {
            const float o[8] = {bflo(oa[q].x), bfhi(oa[q].x), bflo(oa[q].y), bfhi(oa[q].y), bflo(oa[q].z), bfhi(oa[q].z), bflo(oa[q].w), bfhi(oa[q].w)};
            const float z[8] = {bflo(za[q].x), bfhi(za[q].x), bflo(za[q].y), bfhi(za[q].y), bflo(za[q].z), bfhi(za[q].z), bflo(za[q].w), bfhi(za[q].w)};
            float ss = 0.f;
#pragma unroll
            for (int e = 0; e < 8; ++e) ss += o[e] * o[e];
            ss += DPP_F(ss, 0xB1); ss += DPP_F(ss, 0x4E); ss += DPP_F(ss, 0x141); ss += DPP_F(ss, 0x140);
            const float rstd = rsqrtf(ss * (1.f / 128.f) + EPS);
            float r[8];
#pragma unroll
            for (int e = 0; e < 8; ++e) r[e] = o[e] * rstd * wn[e] * silu_f(z[e]);
            v4u w; w.x = cvtpk(r[0], r[1]); w.y = cvtpk(r[2], r[3]); w.z = cvtpk(r[4], r[5]); w.w = cvtpk(r[6], r[7]);
            *(v4u*)(MX + (size_t)(itb + q * NGW) * 1024 + rl * 128 + 8 * sub) = w;
        }
    }
}

__device__ __forceinline__ float gelu_tanh_f(float x) { const float z = 0.7978845608028654f * (x + 0.044715f * x * x * x); return x * __builtin_amdgcn_rcpf(1.f + __expf(-2.f * z)); }
__device__ __forceinline__ void ffn_conv_phase(CParams p, const Ctx cx, int l, int hf) {
    const bf16* U = (const bf16*)(((unsigned char*)p->ws) + WS_U); bf16* ACT = (bf16*)(((unsigned char*)p->ws) + WS_ACT);
    const float* cw = ((const float*)p->ffn_conv) + (size_t)l * 3 * DFF2; const float* cb = ((const float*)p->ffn_conv_bias) + (size_t)l * DFF2;
    const int hw = hf ? 1280 : 1536, coff = hf ? 1536 : 0, ncg = hw / 8, ldu = 2 * hw;
    for (int it = cx.bx * NTHR + cx.tid; it < (M / 16) * ncg; it += gridDim.x * NTHR) {
        const int cgp = it % ncg, rr = it / ncg, m0 = rr * 16, c0 = cgp * 8, pos0 = m0 & (SEQ - 1), gc = coff + c0;
        float wg[3][8], wv[3][8], bg[8], bv[8], pg[2][8], pv[2][8];
#pragma unroll
        for (int j = 0; j < 3; ++j)
#pragma unroll
            for (int e = 0; e < 8; ++e) { wg[j][e] = cw[j * DFF2 + gc + e]; wv[j][e] = cw[j * DFF2 + DFF + gc + e]; }
#pragma unroll
        for (int e = 0; e < 8; ++e) { bg[e] = cb[gc + e]; bv[e] = cb[DFF + gc + e]; }
#pragma unroll
        for (int k = 0; k < 2; ++k) {
            v4u a = {0u, 0u, 0u, 0u}, b = {0u, 0u, 0u, 0u};
            if (pos0 > 0) { a = *(const v4u*)(U + (size_t)(m0 - 2 + k) * ldu + c0); b = *(const v4u*)(U + (size_t)(m0 - 2 + k) * ldu + hw + c0); }
            pg[k][0] = bflo(a.x); pg[k][1] = bfhi(a.x); pg[k][2] = bflo(a.y); pg[k][3] = bfhi(a.y); pg[k][4] = bflo(a.z); pg[k][5] = bfhi(a.z); pg[k][6] = bflo(a.w); pg[k][7] = bfhi(a.w);
            pv[k][0] = bflo(b.x); pv[k][1] = bfhi(b.x); pv[k][2] = bflo(b.y); pv[k][3] = bfhi(b.y); pv[k][4] = bflo(b.z); pv[k][5] = bfhi(b.z); pv[k][6] = bflo(b.w); pv[k][7] = bfhi(b.w);
        }
#pragma unroll 1
        for (int rb = 0; rb < 16; rb += 8) {
            v4u la[8], lb[8];
#pragma unroll
            for (int r = 0; r < 8; ++r) { const int m = m0 + rb + r; la[r] = *(const v4u*)(U + (size_t)m * ldu + c0); lb[r] = *(const v4u*)(U + (size_t)m * ldu + hw + c0); }
#pragma unroll
            for (int r = 0; r < 8; ++r) {
                const int m = m0 + rb + r; const v4u a = la[r], b = lb[r];
                const float cg_[8] = {bflo(a.x), bfhi(a.x), bflo(a.y), bfhi(a.y), bflo(a.z), bfhi(a.z), bflo(a.w), bfhi(a.w)};
                const float cv_[8] = {bflo(b.x), bfhi(b.x), bflo(b.y), bfhi(b.y), bflo(b.z), bfhi(b.z), bflo(b.w), bfhi(b.w)};
                float o[8];
#pragma unroll
                for (int e = 0; e < 8; ++e) {
                    const float gt = wg[0][e] * pg[0][e] + wg[1][e] * pg[1][e] + wg[2][e] * cg_[e] + bg[e];
                    const float vl = wv[0][e] * pv[0][e] + wv[1][e] * pv[1][e] + wv[2][e] * cv_[e] + bv[e];
                    o[e] = gelu_tanh_f(gt) * vl;
                    pg[0][e] = pg[1][e]; pg[1][e] = cg_[e]; pv[0][e] = pv[1][e]; pv[1][e] = cv_[e];
                }
                v4u w; w.x = pk2(o[0], o[1]); w.y = pk2(o[2], o[3]); w.z = pk2(o[4], o[5]); w.w = pk2(o[6], o[7]);
                *(v4u*)(ACT + (size_t)m * DFF + coff + c0) = w;
            }
        }
    }
}


__device__ __forceinline__ void ffn_fixup(CParams p, const Ctx cx, int l, int pm) {
    const bf16* HL = (const bf16*)(((unsigned char*)p->ws) + ((size_t)440 << 20)); bf16* ACT = (bf16*)(((unsigned char*)p->ws) + WS_ACT);
    const float* cw = ((const float*)p->ffn_conv) + (size_t)l * 3 * DFF2; const float* cb = ((const float*)p->ffn_conv_bias) + (size_t)l * DFF2;
    for (int it = cx.tid; it < 4 * 352; it += NTHR) {
        const int si = it / 352, cgp = it % 352, pn = cgp >> 4, c0 = (cgp & 15) * 8, strip = pm * 4 + si, gc = pn * 128 + c0, colp = pn * 256 + c0;
        const bool first = ((strip * 64) & (SEQ - 1)) == 0;
        float ug[4][8], uv[4][8];
#pragma unroll
        for (int rr = 0; rr < 4; ++rr) {
            v4u a = {0u, 0u, 0u, 0u}, b = {0u, 0u, 0u, 0u};
            if (rr >= 2) { a = *(const v4u*)(HL + ((size_t)strip * 4 + (rr - 2)) * 5632 + colp); b = *(const v4u*)(HL + ((size_t)strip * 4 + (rr - 2)) * 5632 + colp + 128); }
            else if (!first) { a = *(const v4u*)(HL + ((size_t)(strip - 1) * 4 + 2 + rr) * 5632 + colp); b = *(const v4u*)(HL + ((size_t)(strip - 1) * 4 + 2 + rr) * 5632 + colp + 128); }
            ug[rr][0] = bflo(a.x); ug[rr][1] = bfhi(a.x); ug[rr][2] = bflo(a.y); ug[rr][3] = bfhi(a.y); ug[rr][4] = bflo(a.z); ug[rr][5] = bfhi(a.z); ug[rr][6] = bflo(a.w); ug[rr][7] = bfhi(a.w);
            uv[rr][0] = bflo(b.x); uv[rr][1] = bfhi(b.x); uv[rr][2] = bflo(b.y); uv[rr][3] = bfhi(b.y); uv[rr][4] = bflo(b.z); uv[rr][5] = bfhi(b.z); uv[rr][6] = bflo(b.w); uv[rr][7] = bfhi(b.w);
        }
#pragma unroll
        for (int ro = 0; ro < 2; ++ro) {
            float o[8];
#pragma unroll
            for (int e = 0; e < 8; ++e) {
                const float g = cw[gc + e] * ug[ro][e] + cw[DFF2 + gc + e] * ug[ro + 1][e] + cw[2 * DFF2 + gc + e] * ug[ro + 2][e] + cb[gc + e];
                const float v = cw[DFF + gc + e] * uv[ro][e] + cw[DFF2 + DFF + gc + e] * uv[ro + 1][e] + cw[2 * DFF2 + DFF + gc + e] * uv[ro + 2][e] + cb[DFF + gc + e];
                o[e] = gelu_tanh_f(g) * v;
            }
            v4u w; w.x = pk2(o[0], o[1]); w.y = pk2(o[2], o[3]); w.z = pk2(o[4], o[5]); w.w = pk2(o[6], o[7]);
            *(v4u*)(ACT + (size_t)(strip * 64 + ro) * DFF + gc) = w;
        }
    }
}

#define XB_TMO      128
#define XB_XCNT(j)  (256  + 64 * (j))
#define XB_XSUB(j)  (1280 + 64 * (j))
#define XB_XGEN(j)  (2304 + 64 * (j))
#define XB_TOP      3328
#define XB_TOPGEN   3392
#define XCD_BAR_WORDS 3456
#define XB_SPIN_CAP (1u << 22)

__device__ __forceinline__ unsigned xb_ld(unsigned* p)              { return __hip_atomic_load(p, __ATOMIC_RELAXED, __HIP_MEMORY_SCOPE_AGENT); }
__device__ __forceinline__ unsigned xb_add(unsigned* p, unsigned v) { return __hip_atomic_fetch_add(p, v, __ATOMIC_RELAXED, __HIP_MEMORY_SCOPE_AGENT); }
__device__ __forceinline__ unsigned xb_xcc_id() { return (unsigned)__builtin_amdgcn_s_getreg((3 << 11) | 20) & 0xFu; }
#define XB_SPIN(cond, bar) do { unsigned _sp = 0; while (cond) { __builtin_amdgcn_s_sleep(1); \
    if ((++_sp & 255u) == 0u) { if (xb_ld(&(bar)[XB_TMO])) break; if (_sp > XB_SPIN_CAP) { atomicAdd(&(bar)[XB_TMO], 1u); break; } } } } while (0)

struct XcdBarrier {
    unsigned* bar; unsigned x;
    volatile LAS unsigned* st;
};

__device__ __forceinline__ XcdBarrier xcd_barrier_post(unsigned* bar, volatile LAS unsigned* st) {
    XcdBarrier b; b.bar = bar; b.x = xb_xcc_id(); b.st = st;
    if (threadIdx.x == 0) (void)xb_add(&bar[XB_XCNT(b.x)], 1u);
    return b;
}
__device__ __forceinline__ void xcd_barrier_complete(unsigned* bar, unsigned x, unsigned& nloc, unsigned& nx) {
    const unsigned G = gridDim.x * gridDim.y * gridDim.z;
    unsigned sum, cnt, mine, sp = 0u;
    for (;;) {
        sum = 0u; cnt = 0u; mine = 0u;
#pragma unroll
        for (unsigned j = 0; j < 16; ++j) { const unsigned c = xb_ld(&bar[XB_XCNT(j)]); sum += c; cnt += (c > 0u) ? 1u : 0u; mine = (j == x) ? c : mine; }
        if (sum == G) break;
        __builtin_amdgcn_s_sleep(1);
        if ((++sp & 255u) == 0u) { if (xb_ld(&bar[XB_TMO])) break; if (sp > XB_SPIN_CAP) { atomicAdd(&bar[XB_TMO], 1u); break; } }
    }
    nloc = mine > 0u ? mine : 1u; nx = cnt > 0u ? cnt : 1u;
}

__device__ __forceinline__ void xcd_barrier(const XcdBarrier& b) {
    asm volatile("s_waitcnt vmcnt(0)" ::: "memory");
    __syncthreads();
    if (threadIdx.x == 0) {
        unsigned* bar = b.bar;
        __builtin_amdgcn_s_waitcnt(0);
        unsigned nloc = b.st[0], nx = b.st[1];
        if (nloc == 0u) { xcd_barrier_complete(bar, b.x, nloc, nx); b.st[0] = nloc; b.st[1] = nx; }
        const unsigned old = xb_add(&bar[XB_XSUB(b.x)], 1u);
        const unsigned gen = old / nloc;
        if (old + 1u == (gen + 1u) * nloc) {
            __builtin_amdgcn_fence(__ATOMIC_RELEASE, "agent");
            asm volatile("s_waitcnt vmcnt(0)" ::: "memory");
            const unsigned og = xb_add(&bar[XB_TOP], 1u);
            const unsigned tg = og / nx;
            if (og + 1u == (tg + 1u) * nx) xb_add(&bar[XB_TOPGEN], 1u);
            else XB_SPIN(xb_ld(&bar[XB_TOPGEN]) == tg, bar);
            __builtin_amdgcn_fence(__ATOMIC_ACQUIRE, "agent");
            xb_add(&bar[XB_XGEN(b.x)], 1u);
            asm volatile("s_waitcnt vmcnt(0)" ::: "memory");
        } else {
            XB_SPIN(xb_ld(&bar[XB_XGEN(b.x)]) == gen, bar);
            __builtin_amdgcn_fence(__ATOMIC_ACQUIRE, "agent");
            asm volatile("s_waitcnt vmcnt(0)" ::: "memory");
        }
    }
    __syncthreads();
}

__global__ void __launch_bounds__(NTHR, 2) mk_fwd(Params pv) {
    extern __shared__ __attribute__((aligned(16))) unsigned char smem[];
    cg::grid_group grid = cg::this_grid();
    LAS unsigned char* lds = (LAS unsigned char*)smem;
    constexpr int NPH = 1 + DEPTH * 9;
    {
        CParams p = (CParams)__builtin_amdgcn_kernarg_segment_ptr();
        Ctx cx; cx.tid = threadIdx.x; cx.bx = blockIdx.x; asm volatile("" : "+v"(cx.tid)); asm volatile("" : "+s"(cx.bx));
        const int lane = cx.tid & 63, wave = __builtin_amdgcn_readfirstlane(cx.tid >> 6);
        convert_weights(p, cx, 0, 0, lds, wave, lane);
        rope_table(p, cx);
        rowwise_phase(p, cx, ((const float*)p->x), nullptr, nullptr, ((const float*)p->pre_mix_norm), 0, lds, wave, lane);
        if (cx.bx == 0) for (int i = cx.tid; i < XCD_BAR_WORDS; i += NTHR) ((unsigned*)(((unsigned char*)p->ws)))[i] = 0u;
        if (cx.tid == 0) { ((volatile LAS unsigned*)(lds + LDS_BYTES - 16))[0] = 0u; ((volatile LAS unsigned*)(lds + LDS_BYTES - 16))[1] = 0u; }
        grid.sync();
    }
    XcdBarrier xbar = xcd_barrier_post((unsigned*)(((unsigned char*)((CParams)__builtin_amdgcn_kernarg_segment_ptr())->ws)), (volatile LAS unsigned*)(lds + LDS_BYTES - 16));
#ifndef PROBE_MASK
#define PROBE_MASK 0
#endif
#define PROBE_PART 0
    for (int ph2 = 2; ph2 < 2 * NPH; ++ph2) {
        const int ph = ph2 >> 1;
        if ((ph2 & 1) && !((PROBE_MASK >> ((ph - 1) % 9)) & 1)) continue;
        CParams p = (CParams)__builtin_amdgcn_kernarg_segment_ptr();
        asm volatile("" : "+s"(p));
        unsigned char* ws = ((unsigned char*)p->ws);
        Ctx cx; cx.tid = threadIdx.x; cx.bx = blockIdx.x; asm volatile("" : "+v"(cx.tid)); asm volatile("" : "+s"(cx.bx));
        const int tid = cx.tid, lane = tid & 63, wave = __builtin_amdgcn_readfirstlane(tid >> 6);
        const int l = (ph - 1) / 9, kk = (ph - 1) % 9, k = kk == 0 ? 0 : (kk == 1 ? 100 : (kk == 2 ? 2 : (kk == 3 ? 101 : (kk == 4 ? 3 : (kk == 5 ? 4 : (kk == 6 ? 5 : (kk == 7 ? 9 : 10)))))));
        if (k == 0 || k == 3 || k == 5 || k == 9) {
            pg8::Gemm g; pg8::EpiAny E; E.ws = ws; E.k = k; E.cw = ((const float*)p->ffn_conv) + (size_t)l * 3 * DFF2; E.cb = ((const float*)p->ffn_conv_bias) + (size_t)l * DFF2; const size_t wo = (l & 1) ? WS_WODD : 0;
            if (k == 0) { g.A = (const bf16*)((float*)p->out); g.Bt = (const bf16*)(ws + WS_WIN + wo); g.N = NIN; g.K = D; }
            else if (k == 3) { g.A = (const bf16*)((float*)p->out); g.Bt = (const bf16*)(ws + WS_WOUT + wo); g.N = D; g.K = D; }
            else if (k == 9) { g.A = (const bf16*)(ws + WS_ACT); g.Bt = (const bf16*)(ws + WS_WDOWN + wo); g.N = D; g.K = DFF; }
            else { g.A = (const bf16*)((float*)p->out); g.Bt = (const bf16*)(ws + WS_WUP + wo); g.N = DFF2; g.K = D; }
            g.M = M;
            pg8::StaticOrder S; S.init(M, g.N, (int)gridDim.x, cx.bx);
            if (k == 9) {
                pg8::Unit uu; for (int i = 0; S.next(i, uu); ++i) ffn_fixup(p, cx, l, uu.pm);
                asm volatile("s_waitcnt vmcnt(0)" ::: "memory"); __syncthreads();
            }
            pg8::gemm_phase<pg8::EpiAny, pg8::StaticOrder, true, true>(lds, g, S, E, tid);
        } else if (k == 100) {
#ifndef NAIVE_SCAN
            d0_phase(p, cx, l, wave, lane);
            asm volatile("s_waitcnt vmcnt(0)" ::: "memory"); __syncthreads();
            for (int un = cx.bx; un < BATCH * 4 * 64; un += gridDim.x) d1_unit(p, cx, un, lds, wave, lane);
#endif
        } else if (k == 101) {
            gate_phase(p, cx, l, wave, lane);
        } else if (k == 2) {
            const int bx = cx.bx, G = gridDim.x;
#ifdef NAIVE_SCAN
            if (bx < 32) scan_naive_unit(p, cx, l, bx, lds, wave, lane);
#else
            if (bx < 32 && !((ph2 & 1) && PROBE_PART == 2)) scan_chunked_unit(p, cx, l, bx, lds, wave, lane);
#endif
#ifdef NAIVE_ATTN
            else { for (int it = (bx - 32) * NTHR + tid; it < M * 8; it += (G - 32) * NTHR) attn_naive_item(p, it); }
#else
            if (bx >= 32 && !((ph2 & 1) && PROBE_PART == 1)) { for (int bu = bx - 32; bu < BATCH * 8 * 16; bu += G - 32) { attn_stage(p, cx, bu, lds); attn_mfma_unit(p, bu * 8 + wave, lane, lds); }
                __syncthreads();
                if (l + 1 < DEPTH && !(ph2 & 1)) convert_weights(p, cx, l + 1, 32, lds, wave, lane); }
#endif
        } else if (k == 4) {
            rowwise_phase(p, cx, nullptr, (const bf16*)(ws + WS_Y), ((const float*)p->post_mix_norm) + l * D, ((const float*)p->pre_ffn_norm) + l * D, -1, lds, wave, lane);
        } else {
            if (l + 1 < DEPTH) {
                rowwise_phase(p, cx, nullptr, (const bf16*)(ws + WS_Y2), ((const float*)p->post_ffn_norm) + l * D, ((const float*)p->pre_mix_norm) + (l + 1) * D, l + 1, lds, wave, lane); }
            else rowwise_phase(p, cx, nullptr, (const bf16*)(ws + WS_Y2), ((const float*)p->post_ffn_norm) + l * D, nullptr, -1, lds, wave, lane);
        }
        if (ph2 + 1 < 2 * NPH) xcd_barrier(xbar);
    }
}

extern "C" void kernel_launch(void* const* d_in, const int* in_sizes, int n_in, void* d_out, int out_size, void* d_ws, size_t ws_size, hipStream_t stream) {
    static int grid_blocks = 0;
    if (grid_blocks == 0) {
        if (n_in != 15 || in_sizes[0] != M * D || out_size != M * D || ws_size < WS_NEED) { fprintf(stderr, "kernel_launch: unexpected shapes / workspace (n_in %d, ws %zu)\n", n_in, ws_size); grid_blocks = -1; return; }
        int dev = 0, cus = 0, per_cu = 0;
        hipGetDevice(&dev); hipDeviceGetAttribute(&cus, hipDeviceAttributeMultiprocessorCount, dev);
        if (hipFuncSetAttribute((const void*)mk_fwd, hipFuncAttributeMaxDynamicSharedMemorySize, LDS_BYTES) != hipSuccess) { fprintf(stderr, "kernel_launch: hipFuncSetAttribute failed\n"); grid_blocks = -1; return; }
        if (hipOccupancyMaxActiveBlocksPerMultiprocessor(&per_cu, (const void*)mk_fwd, NTHR, LDS_BYTES) != hipSuccess || per_cu < 1) { fprintf(stderr, "kernel_launch: occupancy query gave %d\n", per_cu); per_cu = 1; }
        (void)hipGetLastError();
        grid_blocks = cus * 1;
    }
    if (grid_blocks < 0) return;
    Params p{};
    p.x = (GAS const float*)d_in[0]; p.pre_mix_norm = (GAS const float*)d_in[1]; p.w_in = (GAS const float*)d_in[2]; p.dn_conv = (GAS const float*)d_in[3]; p.dn_a_log = (GAS const float*)d_in[4];
    p.dn_dt_bias = (GAS const float*)d_in[5]; p.dn_out_norm = (GAS const float*)d_in[6]; p.w_out = (GAS const float*)d_in[7]; p.post_mix_norm = (GAS const float*)d_in[8]; p.pre_ffn_norm = (GAS const float*)d_in[9];
    p.ffn_up = (GAS const float*)d_in[10]; p.ffn_conv = (GAS const float*)d_in[11]; p.ffn_conv_bias = (GAS const float*)d_in[12]; p.ffn_down = (GAS const float*)d_in[13]; p.post_ffn_norm = (GAS const float*)d_in[14];
    p.out = (GAS float*)d_out; p.ws = (GAS unsigned char*)d_ws;
    void* args[] = {&p};
    hipError_t e = hipLaunchCooperativeKernel((const void*)mk_fwd, dim3(grid_blocks), dim3(NTHR), args, LDS_BYTES, stream);
    if (e != hipSuccess) fprintf(stderr, "kernel_launch: cooperative launch failed: %s (grid %d)\n", hipGetErrorString(e), grid_blocks);
}
```

```cpp
#include <hip/hip_runtime.h>
#include <hip/hip_cooperative_groups.h>
#include <cstdio>
#include <cstdint>
namespace cg = cooperative_groups;

namespace pg8 {
#define PG8_LAS __attribute__((address_space(3)))
typedef unsigned short bf16_t;
typedef short bf16x8 __attribute__((ext_vector_type(8)));
typedef float f32x4 __attribute__((ext_vector_type(4)));
typedef unsigned u32x4 __attribute__((ext_vector_type(4)));
constexpr int BM = 256, BK = 64, HALF = 128, HTB = HALF * BK * 2  , STAGE_BYTES = 8 * HTB, NXCD = 8, WGM = 8;

__host__ __device__ __forceinline__ int lds_byte(int r, int c) { const int st = (r >> 4) * 2 + (c >> 5), rr = r & 15, cc = c & 31, ob = rr * 64 + cc * 2; return st * 1024 + (ob ^ (((ob >> 9) & 1) << 5)); }
__host__ __device__ __forceinline__ void stage_rc(int b, int& R, int& C) { const int st = b / 1024, sb = b % 1024, swz = sb ^ (((sb >> 9) & 1) << 5); R = (st >> 1) * 16 + swz / 64; C = (st & 1) * 32 + (swz % 64) / 2; }
__host__ __device__ __forceinline__ int perm32(int rho) { const int n = rho >> 4, i = rho & 15; return 8 * (i >> 2) + 4 * n + (i & 3); }

struct Unit { int pm, pn; };
struct Gemm { const bf16_t* A; const bf16_t* Bt; int M, N, K; };

struct StaticOrder {
    int nM, nN, nwg, G, c;
    __host__ __device__ void init(int M, int N, int G_, int c_) { nM = M / BM; nN = N / BM; nwg = nM * nN; G = G_; c = c_; }
    __host__ __device__ bool next(int i, Unit& u) const {
        const long L = (long)i * G + c; if (L >= nwg) return false;
        int wgid = (int)L; { const int q = nwg / NXCD, r = nwg % NXCD, xcd = wgid % NXCD, off = wgid / NXCD; wgid = (xcd < r ? xcd * (q + 1) : r * (q + 1) + (xcd - r) * q) + off; }
        const int nig = WGM * nN, gid = wgid / nig, fm = gid * WGM, gsz = (nM - fm) < WGM ? (nM - fm) : WGM;
        u.pm = fm + ((wgid % nig) % gsz); u.pn = (wgid % nig) / gsz; return true;
    }
    __device__ __forceinline__ void a_ready(const Unit&) const {}
    __device__ __forceinline__ void done(const Unit&) const {}
};

__device__ __forceinline__ unsigned cvt_pk_bf16(float lo, float hi) { unsigned r; asm volatile("v_cvt_pk_bf16_f32 %0, %1, %2" : "=v"(r) : "v"(lo), "v"(hi)); return r; }

struct EpiBf16 {
    static constexpr bool PERM = true, AFTER_DRAIN = false;
    bf16_t* O0; int ld0; int c1; bf16_t* O1; int ld1; int c2; bf16_t* O2; int ld2;
    __device__ __forceinline__ void operator()(const f32x4 (&acc)[2][2][4][2], const Unit& u, int wr, int wc, int fr, int fq) const {
        const int row0 = u.pm * BM + wr * 64 + fr; int colt = u.pn * BM; bf16_t* base = O0; int ldc = ld0;
        if (colt >= c2) { base = O2; ldc = ld2; colt -= c2; } else if (colt >= c1) { base = O1; ldc = ld1; colt -= c1; }
        const int col0 = colt + wc * 32 + 8 * fq;
#pragma unroll
        for (int ai = 0; ai < 2; ++ai)
#pragma unroll
            for (int m = 0; m < 4; ++m) { bf16_t* rowp = base + (size_t)(row0 + ai * HALF + m * 16) * ldc + col0;
#pragma unroll
                for (int bj = 0; bj < 2; ++bj) { const f32x4 v0 = acc[ai][bj][m][0], v1 = acc[ai][bj][m][1];
                    u32x4 w; w.x = cvt_pk_bf16(v0[0], v0[1]); w.y = cvt_pk_bf16(v0[2], v0[3]); w.z = cvt_pk_bf16(v1[0], v1[1]); w.w = cvt_pk_bf16(v1[2], v1[3]);
                    *(u32x4*)(rowp + bj * HALF) = w; } }
    }
};
struct EpiAny {
    static constexpr bool PERM = true, AFTER_DRAIN = false;
    unsigned char* ws; int k; const float* cw; const float* cb;
    __device__ __forceinline__ void operator()(const f32x4 (&acc)[2][2][4][2], const Unit& u, int wr, int wc, int fr, int fq) const {
        const int row0 = u.pm * BM + wr * 64 + fr; int colt = u.pn * BM;
        if (k == 5) {
            bf16_t* act = (bf16_t*)(ws + ((size_t)96 << 20)); bf16_t* halo = (bf16_t*)(ws + ((size_t)440 << 20));
            const int ch0 = u.pn * 128 + wc * 32 + 8 * fq;
#define ROR1(x) __builtin_bit_cast(float, __builtin_amdgcn_update_dpp(0, __builtin_bit_cast(int, (x)), 0x121, 0xf, 0xf, false))
#define ROR2(x) __builtin_bit_cast(float, __builtin_amdgcn_update_dpp(0, __builtin_bit_cast(int, (x)), 0x122, 0xf, 0xf, false))
#pragma unroll
            for (int n = 0; n < 2; ++n) {
                float wg[3][4], wv[3][4], bg[4], bv[4];
#pragma unroll
                for (int e = 0; e < 4; ++e) { const int c = ch0 + 4 * n + e;
#pragma unroll
                    for (int j = 0; j < 3; ++j) { wg[j][e] = cw[j * 5632 + c]; wv[j][e] = cw[j * 5632 + 2816 + c]; }
                    bg[e] = cb[c]; bv[e] = cb[2816 + c]; }
#pragma unroll
                for (int ai = 0; ai < 2; ++ai) {
                    const int strip = u.pm * 4 + ai * 2 + wr;
#pragma unroll
                    for (int m = 0; m < 4; ++m) {
                        const f32x4 gq = acc[ai][0][m][n], vq = acc[ai][1][m][n]; float o[4];
                        const f32x4 gp = m ? acc[ai][0][m ? m - 1 : 0][n] : (f32x4){0.f, 0.f, 0.f, 0.f}, vp = m ? acc[ai][1][m ? m - 1 : 0][n] : (f32x4){0.f, 0.f, 0.f, 0.f};
#pragma unroll
                        for (int e = 0; e < 4; ++e) {
                            const float g = gq[e], v = vq[e];
                            const float sg1 = fr == 15 ? gp[e] : g, sg2 = fr >= 14 ? gp[e] : g, sv1 = fr == 15 ? vp[e] : v, sv2 = fr >= 14 ? vp[e] : v;
                            const float a1g = ROR1(sg1), a2g = ROR2(sg2), a1v = ROR1(sv1), a2v = ROR2(sv2);
                            const float gc = wg[0][e] * a2g + wg[1][e] * a1g + wg[2][e] * g + bg[e];
                            const float vc = wv[0][e] * a2v + wv[1][e] * a1v + wv[2][e] * v + bv[e];
                            const float z = 0.7978845608028654f * (gc + 0.044715f * gc * gc * gc);
                            o[e] = gc * __builtin_amdgcn_rcpf(1.f + __expf(-2.f * z)) * vc;
                        }
                        typedef unsigned u32x2 __attribute__((ext_vector_type(2)));
                        u32x2 w; w.x = cvt_pk_bf16(o[0], o[1]); w.y = cvt_pk_bf16(o[2], o[3]);
                        *(u32x2*)(act + (size_t)(row0 + ai * HALF + m * 16) * 2816 + ch0 + 4 * n) = w;
                        if ((m == 0 && fr < 2) || (m == 3 && fr >= 14)) {
                            const int slot = (m == 0) ? fr : fr - 12;
                            bf16_t* hp = halo + ((size_t)strip * 4 + slot) * 5632 + u.pn * 256 + wc * 32 + 8 * fq + 4 * n;
                            u32x2 hg, hv; hg.x = cvt_pk_bf16(gq[0], gq[1]); hg.y = cvt_pk_bf16(gq[2], gq[3]); hv.x = cvt_pk_bf16(vq[0], vq[1]); hv.y = cvt_pk_bf16(vq[2], vq[3]);
                            *(u32x2*)hp = hg; *(u32x2*)(hp + 128) = hv;
                        }
                    }
                }
            }
#undef ROR1
#undef ROR2
        } else {
            bf16_t* base; int ldc;
            if (k == 0) { if (colt >= 2048) { base = (bf16_t*)(ws + ((size_t)128 << 20)); ldc = 1536; colt -= 2048; } else if (colt >= 1536) { base = (bf16_t*)(ws + ((size_t)96 << 20)); ldc = 512; colt -= 1536; }
                          else { base = (bf16_t*)(ws + ((size_t)224 << 20)); ldc = 1536; } }
            else if (k == 3) { base = (bf16_t*)(ws + ((size_t)96 << 20)); ldc = 1024; }
            else if (k == 9) { base = (bf16_t*)(ws + ((size_t)272 << 20)); ldc = 1024; }
            else { base = (bf16_t*)(ws + ((size_t)272 << 20)); ldc = (k == 5) ? 3072 : 2560; }
            const int col0 = colt + wc * 32 + 8 * fq;
#pragma unroll
            for (int ai = 0; ai < 2; ++ai)
#pragma unroll
                for (int m = 0; m < 4; ++m) { bf16_t* rowp = base + (size_t)(row0 + ai * HALF + m * 16) * ldc + col0;
#pragma unroll
                    for (int bj = 0; bj < 2; ++bj) { const f32x4 v0 = acc[ai][bj][m][0], v1 = acc[ai][bj][m][1];
                        u32x4 w; w.x = cvt_pk_bf16(v0[0], v0[1]); w.y = cvt_pk_bf16(v0[2], v0[3]); w.z = cvt_pk_bf16(v1[0], v1[1]); w.w = cvt_pk_bf16(v1[2], v1[3]);
                        *(u32x4*)(rowp + bj * HALF) = w; } }
        }
    }
};
struct EpiF32 {
    static constexpr bool PERM = true, AFTER_DRAIN = false;
    float* O; int ldc;
    __device__ __forceinline__ void operator()(const f32x4 (&acc)[2][2][4][2], const Unit& u, int wr, int wc, int fr, int fq) const {
        const int row0 = u.pm * BM + wr * 64 + fr; const int col0 = u.pn * BM + wc * 32 + 8 * fq;
#pragma unroll
        for (int ai = 0; ai < 2; ++ai)
#pragma unroll
            for (int m = 0; m < 4; ++m) { float* rowp = O + (size_t)(row0 + ai * HALF + m * 16) * ldc + col0;
#pragma unroll
                for (int bj = 0; bj < 2; ++bj) { *(f32x4*)(rowp + bj * HALF) = acc[ai][bj][m][0]; *(f32x4*)(rowp + bj * HALF + 4) = acc[ai][bj][m][1]; } }
    }
};

template <class Epi, class Sched, bool ALIGN_EPI = false, bool SP2 = false>
__device__ __forceinline__ void gemm_phase(PG8_LAS unsigned char* lds, const Gemm g, const Sched& S, const Epi& E, const int tid) {
    const int wid = __builtin_amdgcn_readfirstlane(tid >> 6), lane = tid & 63, wr = wid >> 2, wc = wid & 3, fr = lane & 15, fq = lane >> 4;
    const int K = g.K, nt = K / BK;
    unsigned voffA[2], voffB[2];
#pragma unroll
    for (int i = 0; i < 2; ++i) { int R, C; stage_rc(tid * 16 + i * 8192, R, C); const int Rb = Epi::PERM ? ((R & ~31) + perm32(R & 31)) : R;
        voffA[i] = (unsigned)(R * K + C) * 2u; voffB[i] = (unsigned)(Rb * K + C) * 2u; }
    const size_t kstep = (size_t)(BK * 2);
    const size_t hstep = (size_t)HALF * K * 2;
    const size_t tstep = 2 * hstep;
    const unsigned ldsw = (unsigned)wid * 1024u;
    const int aoff = lds_byte(wr * 64 + fr, fq * 8), boff = lds_byte(wc * 32 + fr, fq * 8);
#define PG8_SA(b, h) (((b) * 2 + (h)) * HTB)
#define PG8_SB(b, h) ((4 + (b) * 2 + (h)) * HTB)
#define PG8_STAGE(bufoff, gbase, voff) do { _Pragma("unroll") for (int _i = 0; _i < 2; ++_i) \
        __builtin_amdgcn_global_load_lds((const unsigned*)((const char*)(gbase) + (voff)[_i]), (PG8_LAS unsigned*)(lds + (bufoff) + ldsw + _i * 8192), 16, 0, 0); } while (0)
#define PG8_LDA(dst, b, h) do { _Pragma("unroll") for (int m = 0; m < 4; ++m) _Pragma("unroll") for (int k = 0; k < 2; ++k) dst[m][k] = *(const PG8_LAS bf16x8*)(lds + PG8_SA(b, h) + aoff + m * 2048 + k * 1024); } while (0)
#define PG8_LDB(dst, b, h) do { _Pragma("unroll") for (int n = 0; n < 2; ++n) _Pragma("unroll") for (int k = 0; k < 2; ++k) dst[n][k] = *(const PG8_LAS bf16x8*)(lds + PG8_SB(b, h) + boff + n * 2048 + k * 1024); } while (0)
#define PG8_MMA(ai, bj, At, Bt) do { __builtin_amdgcn_s_setprio(1); _Pragma("unroll") for (int m = 0; m < 4; ++m) _Pragma("unroll") for (int n = 0; n < 2; ++n) _Pragma("unroll") for (int k = 0; k < 2; ++k) \
        acc[ai][bj][m][n] = __builtin_amdgcn_mfma_f32_16x16x32_bf16(Bt[n][k], At[m][k], acc[ai][bj][m][n], 0, 0, 0); __builtin_amdgcn_s_setprio(0); } while (0)
#define PG8_WAIT_V(n) asm volatile("s_waitcnt vmcnt(" #n ")" ::: "memory")
#define PG8_WAIT_L(n) asm volatile("s_waitcnt lgkmcnt(" #n ")" ::: "memory")
#define PG8_BAR __builtin_amdgcn_s_barrier()
#define PG8_SCHED __builtin_amdgcn_sched_barrier(0)
    Unit cur, nxt; int ui = 0;
    if (!S.next(0, cur)) return;
    f32x4 acc[2][2][4][2];
#pragma unroll
    for (int a = 0; a < 2; ++a)
#pragma unroll
        for (int b = 0; b < 2; ++b)
#pragma unroll
            for (int m = 0; m < 4; ++m)
#pragma unroll
                for (int n = 0; n < 2; ++n) acc[a][b][m][n] = (f32x4){0.f, 0.f, 0.f, 0.f};
    bf16x8 At[4][2], B0[2][2], B1[2][2];
    const char* cA = (const char*)g.A + (size_t)cur.pm * tstep; const char* cB = (const char*)g.Bt + (size_t)cur.pn * tstep;
    S.a_ready(cur);
    if constexpr (SP2) {
        PG8_STAGE(PG8_SB(0, 0), cB, voffB); PG8_STAGE(PG8_SB(0, 1), cB + hstep, voffB); PG8_STAGE(PG8_SA(0, 0), cA, voffA); PG8_STAGE(PG8_SA(0, 1), cA + hstep, voffA);
        if (wr == 1) PG8_BAR;
        PG8_WAIT_V(2); PG8_BAR;
        PG8_STAGE(PG8_SB(1, 0), cB + kstep, voffB); PG8_STAGE(PG8_SA(1, 0), cA + kstep, voffA); PG8_STAGE(PG8_SB(1, 1), cB + hstep + kstep, voffB);
        PG8_WAIT_V(6); PG8_BAR;
    } else {
        PG8_STAGE(PG8_SB(0, 0), cB, voffB); PG8_STAGE(PG8_SA(0, 0), cA, voffA); PG8_STAGE(PG8_SB(0, 1), cB + hstep, voffB); PG8_STAGE(PG8_SA(0, 1), cA + hstep, voffA);
        if (wr == 1) PG8_BAR;
        PG8_WAIT_V(4); PG8_BAR;
        PG8_STAGE(PG8_SB(1, 0), cB + kstep, voffB); PG8_STAGE(PG8_SA(1, 0), cA + kstep, voffA); PG8_STAGE(PG8_SB(1, 1), cB + hstep + kstep, voffB);
        PG8_WAIT_V(6); PG8_BAR;
    }
    for (;;) {
        const bool has_next = S.next(ui + 1, nxt);
        const char* nA = has_next ? (const char*)g.A + (size_t)nxt.pm * tstep : cA; const char* nB = has_next ? (const char*)g.Bt + (size_t)nxt.pn * tstep : cB;
        for (int t = 0; t < nt; t += 2) {
            const bool last = (t == nt - 2);
            const char* a1 = cA + (size_t)(t + 1) * kstep;
            const char* a2 = last ? nA : cA + (size_t)(t + 2) * kstep; const char* b2 = last ? nB : cB + (size_t)(t + 2) * kstep;
            const char* a3 = a2 + kstep; const char* b3 = b2 + kstep;
            if (last && has_next) S.a_ready(nxt);
            if constexpr (SP2) {
            PG8_LDB(B0, 0, 0); PG8_LDB(B1, 0, 1); PG8_SCHED; PG8_LDA(At, 0, 0); PG8_STAGE(PG8_SA(1, 1), a1 + hstep, voffA);
            PG8_WAIT_V(8); PG8_WAIT_L(0); PG8_BAR; PG8_MMA(0, 0, At, B0); PG8_MMA(0, 1, At, B1); PG8_BAR; PG8_SCHED;
            PG8_LDA(At, 0, 1); PG8_STAGE(PG8_SB(0, 0), b2, voffB); PG8_STAGE(PG8_SB(0, 1), b2 + hstep, voffB); PG8_STAGE(PG8_SA(0, 0), a2, voffA);
            PG8_WAIT_V(8); PG8_WAIT_L(0); PG8_BAR; PG8_MMA(1, 0, At, B0); PG8_MMA(1, 1, At, B1); PG8_BAR; PG8_SCHED;
            PG8_LDB(B0, 1, 0); PG8_LDB(B1, 1, 1); PG8_SCHED; PG8_LDA(At, 1, 0); PG8_STAGE(PG8_SA(0, 1), a2 + hstep, voffA);
            PG8_WAIT_V(8); PG8_WAIT_L(0); PG8_BAR; PG8_MMA(0, 0, At, B0); PG8_MMA(0, 1, At, B1); PG8_BAR; PG8_SCHED;
            PG8_LDA(At, 1, 1); PG8_STAGE(PG8_SB(1, 0), b3, voffB); PG8_STAGE(PG8_SB(1, 1), b3 + hstep, voffB); PG8_STAGE(PG8_SA(1, 0), a3, voffA);
            PG8_WAIT_V(8); PG8_WAIT_L(0); PG8_BAR; PG8_MMA(1, 0, At, B0); PG8_MMA(1, 1, At, B1); PG8_BAR; PG8_SCHED;
            } else {
            PG8_LDB(B0, 0, 0); PG8_SCHED; PG8_LDA(At, 0, 0); PG8_STAGE(PG8_SA(1, 1), a1 + hstep, voffA);
            PG8_WAIT_L(8); PG8_BAR; PG8_WAIT_L(0); PG8_MMA(0, 0, At, B0); PG8_BAR; PG8_SCHED;
            PG8_LDB(B1, 0, 1); PG8_STAGE(PG8_SB(0, 0), b2, voffB);
            PG8_BAR; PG8_WAIT_L(0); PG8_MMA(0, 1, At, B1); PG8_BAR;
            PG8_LDA(At, 0, 1); PG8_STAGE(PG8_SA(0, 0), a2, voffA);
            PG8_BAR; PG8_WAIT_L(0); PG8_MMA(1, 0, At, B0); PG8_BAR; PG8_SCHED;
            PG8_STAGE(PG8_SB(0, 1), b2 + hstep, voffB);
            PG8_WAIT_V(6); PG8_BAR; PG8_MMA(1, 1, At, B1); PG8_BAR;
            PG8_LDB(B0, 1, 0); PG8_SCHED; PG8_LDA(At, 1, 0); PG8_STAGE(PG8_SA(0, 1), a2 + hstep, voffA);
            PG8_WAIT_L(8); PG8_BAR; PG8_WAIT_L(0); PG8_MMA(0, 0, At, B0); PG8_BAR; PG8_SCHED;
            PG8_LDB(B1, 1, 1); PG8_STAGE(PG8_SB(1, 0), b3, voffB);
            PG8_BAR; PG8_WAIT_L(0); PG8_MMA(0, 1, At, B1); PG8_BAR;
            PG8_LDA(At, 1, 1); PG8_STAGE(PG8_SA(1, 0), a3, voffA);
            PG8_BAR; PG8_WAIT_L(0); PG8_MMA(1, 0, At, B0); PG8_BAR; PG8_SCHED;
            PG8_STAGE(PG8_SB(1, 1), b3 + hstep, voffB);
            PG8_WAIT_V(6); PG8_BAR; PG8_MMA(1, 1, At, B1); PG8_BAR;
            }
        }
        if constexpr (ALIGN_EPI) { if (wr == 0) PG8_BAR; }
        if constexpr (!Epi::AFTER_DRAIN) { E(acc, cur, wr, wc, fr, fq); S.done(cur); }
        if (!has_next) break;
#pragma unroll
        for (int a = 0; a < 2; ++a)
#pragma unroll
            for (int b = 0; b < 2; ++b)
#pragma unroll
                for (int m = 0; m < 4; ++m)
#pragma unroll
                    for (int n = 0; n < 2; ++n) acc[a][b][m][n] = (f32x4){0.f, 0.f, 0.f, 0.f};
        cur = nxt; cA = nA; cB = nB; ++ui;
        if constexpr (ALIGN_EPI) { if (wr == 1) PG8_BAR; }
    }
    PG8_WAIT_V(0);
    if constexpr (!ALIGN_EPI) { if (wr == 0) PG8_BAR; }
    PG8_BAR;
    if constexpr (Epi::AFTER_DRAIN) { E.fused(acc, cur, wr, wc, fr, fq, lds, wid, lane); S.done(cur); }
#undef PG8_SA
#undef PG8_SB
#undef PG8_STAGE
#undef PG8_LDA
#undef PG8_LDB
#undef PG8_MMA
#undef PG8_WAIT_V
#undef PG8_WAIT_L
#undef PG8_BAR
#undef PG8_SCHED
}
}

#define LAS __attribute__((address_space(3)))
typedef unsigned short bf16;
typedef unsigned v4u __attribute__((ext_vector_type(4)));
typedef unsigned v2u __attribute__((ext_vector_type(2)));
typedef float f32x4 __attribute__((ext_vector_type(4)));
typedef short bf16x8 __attribute__((ext_vector_type(8)));
constexpr int NTHR = 512, NWAVES = 8;
constexpr int BATCH = 8, SEQ = 4096, M = BATCH * SEQ, D = 1024, DEPTH = 4;
constexpr int IN_W = 3592, NIN = 3584, DFF = 2816, DFF2 = 5632, HALF_FF = 1408;
constexpr float EPS = 1e-6f;
constexpr size_t MiB = 1u << 20;
constexpr size_t WS_WIN = 1 * MiB, WS_WOUT = 8 * MiB, WS_WUP = 10 * MiB, WS_WDOWN = 21 * MiB;
constexpr size_t WS_ROPE = 27 * MiB, WS_GATES = 28 * MiB;
constexpr size_t WS_XB = 32 * MiB;
constexpr size_t WS_Z = 96 * MiB, WS_BQKV = 128 * MiB, WS_AQKV = 224 * MiB, WS_QKVN = 320 * MiB;
constexpr size_t WS_Y = 96 * MiB;
constexpr size_t WS_ACT = 96 * MiB, WS_U = 272 * MiB, WS_Y2 = 272 * MiB;
constexpr size_t WS_NEED = 506 * MiB;
constexpr size_t WS_WODD = 479 * MiB;
constexpr int LDS_BYTES = 163840;
static_assert(WS_Y == (96u << 20) && WS_Y2 == (272u << 20) && WS_BQKV == (128u << 20) && WS_Z == (96u << 20) && WS_AQKV == (224u << 20) && WS_U == (272u << 20), "EpiAny hard-codes these offsets");

#define GAS __attribute__((address_space(1)))
struct Params {
    GAS const float* x; GAS const float* pre_mix_norm; GAS const float* w_in; GAS const float* dn_conv; GAS const float* dn_a_log; GAS const float* dn_dt_bias; GAS const float* dn_out_norm;
    GAS const float* w_out; GAS const float* post_mix_norm; GAS const float* pre_ffn_norm; GAS const float* ffn_up; GAS const float* ffn_conv; GAS const float* ffn_conv_bias;
    GAS const float* ffn_down; GAS const float* post_ffn_norm; GAS float* out; GAS unsigned char* ws;
};

typedef __attribute__((address_space(4))) const Params* CParams;
struct Ctx { int tid, bx; };
__device__ __forceinline__ unsigned f2bf(float f) { unsigned u = __float_as_uint(f); return (u + 0x7fffu + ((u >> 16) & 1u)) >> 16; }
typedef __bf16 bf16x2_t __attribute__((ext_vector_type(2)));
typedef float f32x2_t __attribute__((ext_vector_type(2)));
__device__ __forceinline__ unsigned cvtpk(float lo, float hi) { f32x2_t v = {lo, hi}; bf16x2_t b = __builtin_convertvector(v, bf16x2_t); return __builtin_bit_cast(unsigned, b); }
__device__ __forceinline__ unsigned pk2(float lo, float hi) { return cvtpk(lo, hi); }
__device__ __forceinline__ float bflo(unsigned u) { return __uint_as_float(u << 16); }
__device__ __forceinline__ float bfhi(unsigned u) { return __uint_as_float(u & 0xffff0000u); }
__device__ __forceinline__ float dpp_add(float v, const int ctrl_dummy) { return v; }
#define DPP_F(v, ctrl) __builtin_bit_cast(float, __builtin_amdgcn_update_dpp(0, __builtin_bit_cast(int, (v)), (ctrl), 0xf, 0xf, true))
__device__ __forceinline__ float wave_sum(float v) {
    v += DPP_F(v, 0xB1); v += DPP_F(v, 0x4E); v += DPP_F(v, 0x141); v += DPP_F(v, 0x140);
    const float r0 = __builtin_bit_cast(float, __builtin_amdgcn_readlane(__builtin_bit_cast(int, v), 0)), r1 = __builtin_bit_cast(float, __builtin_amdgcn_readlane(__builtin_bit_cast(int, v), 16));
    const float r2 = __builtin_bit_cast(float, __builtin_amdgcn_readlane(__builtin_bit_cast(int, v), 32)), r3 = __builtin_bit_cast(float, __builtin_amdgcn_readlane(__builtin_bit_cast(int, v), 48));
    return (r0 + r1) + (r2 + r3);
}
__device__ __forceinline__ float shflx(float v, int o, int lane) { return __builtin_bit_cast(float, __builtin_amdgcn_ds_bpermute((lane ^ o) << 2, __builtin_bit_cast(int, v))); }
__device__ __forceinline__ float silu_f(float y) { return y * __builtin_amdgcn_rcpf(1.f + __expf(-y)); }

__device__ __forceinline__ void transpose_item(const float* W, int ldw, int src_col0, int k0, bf16* WT, int K, int dst_row0, LAS float* scr, int lane) {
#pragma unroll 8
    for (int i = 0; i < 32; ++i) { const int kk = 2 * i + (lane >> 5); scr[kk * 33 + (lane & 31)] = W[(size_t)(k0 + kk) * ldw + src_col0 + (lane & 31)]; }
    asm volatile("s_waitcnt lgkmcnt(0)" ::: "memory");
    const int c = lane & 7;
#pragma unroll
    for (int j = 0; j < 4; ++j) { const int n = (lane >> 3) + 8 * j; const LAS float* s = scr + (8 * c) * 33 + n;
        v4u o; o.x = pk2(s[0 * 33], s[1 * 33]); o.y = pk2(s[2 * 33], s[3 * 33]); o.z = pk2(s[4 * 33], s[5 * 33]); o.w = pk2(s[6 * 33], s[7 * 33]);
        *(v4u*)(WT + (size_t)(dst_row0 + n) * K + k0 + 8 * c) = o; }
    asm volatile("s_waitcnt lgkmcnt(0)" ::: "memory");
}
__device__ __forceinline__ void convert_weights(CParams p, const Ctx cx, int l, int b0, LAS unsigned char* lds, int wave, int lane) {
    LAS float* scr = (LAS float*)(lds + 65536 + wave * 8448);
    const int gw = (cx.bx - b0) * NWAVES + wave, NGW = ((int)gridDim.x - b0) * NWAVES; const size_t wo = (l & 1) ? WS_WODD : 0;
    constexpr int I_IN = 16 * 112, I_OUT = 16 * 32, I_UP = 16 * 176, I_DN = 44 * 32;
    bf16* WinT = (bf16*)(((unsigned char*)p->ws) + WS_WIN + wo); bf16* WoutT = (bf16*)(((unsigned char*)p->ws) + WS_WOUT + wo); bf16* WupT = (bf16*)(((unsigned char*)p->ws) + WS_WUP + wo); bf16* WdnT = (bf16*)(((unsigned char*)p->ws) + WS_WDOWN + wo);
    for (int it = gw; it < I_IN + I_OUT + I_UP + I_DN; it += NGW) {
        int r = it;
        if (r < I_IN) { const int kb = r / 112, nb = r % 112, d0 = nb * 32, s0 = d0 < 2048 ? d0 : d0 + 8;
            transpose_item(((const float*)p->w_in) + (size_t)l * D * IN_W, IN_W, s0, kb * 64, WinT, D, d0, scr, lane); continue; } r -= I_IN;
        if (r < I_OUT) { const int kb = r / 32, nb = r % 32;
            transpose_item(((const float*)p->w_out) + (size_t)l * D * D, D, nb * 32, kb * 64, WoutT, D, nb * 32, scr, lane); continue; } r -= I_OUT;
        if (r < I_UP) { const int kb = r / 176, nb = r % 176, d0 = nb * 32, s0 = ((d0 & 255) >> 7) * DFF + (d0 >> 8) * 128 + (d0 & 127);
            transpose_item(((const float*)p->ffn_up) + (size_t)l * D * DFF2, DFF2, s0, kb * 64, WupT, D, d0, scr, lane); continue; } r -= I_UP;
        { const int kb = r / 32, nb = r % 32;
            transpose_item(((const float*)p->ffn_down) + (size_t)l * DFF * D, D, nb * 32, kb * 64, WdnT, DFF, nb * 32, scr, lane); }
    }
}
__device__ __forceinline__ void rope_table(CParams p, const Ctx cx) {
    float* tab = (float*)(((unsigned char*)p->ws) + WS_ROPE);
    const float invf[8] = {1.0f, 0.1939227432012558f, 0.03760603070259094f, 0.007292664609849453f, 0.0014142135623842478f, 0.00027424818836152554f, 5.3182957344688475e-05f, 1.0313385246263351e-05f};
    for (int i = cx.bx * NTHR + cx.tid; i < SEQ * 8; i += gridDim.x * NTHR) {
        const int pos = i >> 3, f = i & 7;
        float fr = invf[0];
#pragma unroll
        for (int q = 1; q < 8; ++q) fr = (f == q) ? invf[q] : fr;
        const float ang = (float)pos * fr;
        const double ad = (double)ang; const double n = __builtin_rint(ad * 0.15915494309189535); const float r = (float)(ad - n * 6.283185307179586);
        tab[pos * 16 + f] = cosf(r); tab[pos * 16 + 8 + f] = sinf(r);
    }
}

__device__ __forceinline__ void rowwise_phase(CParams p, const Ctx cx, const float* xsrc, const bf16* y, const float* wpost, const float* wpre, int gates_l, LAS unsigned char* lds, int wave, int lane) {
    LAS f32x4* gt = (LAS f32x4*)lds;
    if (gates_l >= 0) {
        const float* Wg = ((const float*)p->w_in) + (size_t)gates_l * D * IN_W + 2048;
        for (int i = cx.tid; i < 2048; i += NTHR) { const int ln = i & 63, half = (i >> 6) & 1, je = i >> 7, j = je >> 2, e = je & 3; const int k = 4 * ln + 256 * j + e;
            const float* s = Wg + (size_t)k * IN_W + 4 * half; gt[i] = (f32x4){s[0], s[1], s[2], s[3]}; }
        __syncthreads();
    }
    float* outp = ((float*)p->out); bf16* H = (bf16*)((float*)p->out); bf16* XB = (bf16*)(((unsigned char*)p->ws) + WS_XB); float* G = (float*)(((unsigned char*)p->ws) + WS_GATES);
    const int gw = cx.bx * NWAVES + wave, NGW = gridDim.x * NWAVES;
    f32x4 wpo[4], wpr[4];
#pragma unroll
    for (int j = 0; j < 4; ++j) { wpo[j] = wpost ? ((const f32x4*)wpost)[lane + 64 * j] : (f32x4){0.f, 0.f, 0.f, 0.f}; wpr[j] = wpre ? ((const f32x4*)wpre)[lane + 64 * j] : (f32x4){0.f, 0.f, 0.f, 0.f}; }
    constexpr int RB = 4;
    for (int rowb = gw; rowb < M; rowb += NGW * RB) {
        f32x4 xa[RB][4]; v2u ya[RB][4];
#pragma unroll
        for (int q = 0; q < RB; ++q) { const int row = rowb + q * NGW;
#pragma unroll
            for (int j = 0; j < 4; ++j) { if (xsrc) xa[q][j] = ((const f32x4*)(xsrc + (size_t)row * D))[lane + 64 * j]; else { const v2u xr = ((const v2u*)(XB + (size_t)row * D))[lane + 64 * j]; xa[q][j] = (f32x4){bflo(xr.x), bfhi(xr.x), bflo(xr.y), bfhi(xr.y)}; }
                if (y) ya[q][j] = ((const v2u*)(y + (size_t)row * D))[lane + 64 * j]; } }
#pragma unroll
        for (int q = 0; q < RB; ++q) {
        const int row = rowb + q * NGW;
        f32x4 xv[4];
#pragma unroll
        for (int j = 0; j < 4; ++j) xv[j] = xa[q][j];
        if (y) {
            f32x4 yv[4]; float s = 0.f;
#pragma unroll
            for (int j = 0; j < 4; ++j) { const v2u yr = ya[q][j]; yv[j] = (f32x4){bflo(yr.x), bfhi(yr.x), bflo(yr.y), bfhi(yr.y)}; s += (yv[j].x * yv[j].x + yv[j].y * yv[j].y) + (yv[j].z * yv[j].z + yv[j].w * yv[j].w); }
            const float ry = rsqrtf(wave_sum(s) * (1.f / D) + EPS);
#pragma unroll
            for (int j = 0; j < 4; ++j) xv[j] = xv[j] + yv[j] * ry * wpo[j];
        }
        if (wpre) {
#pragma unroll
            for (int j = 0; j < 4; ++j) { v2u o; o.x = pk2(xv[j].x, xv[j].y); o.y = pk2(xv[j].z, xv[j].w); ((v2u*)(XB + (size_t)row * D))[lane + 64 * j] = o; }
        } else {
#pragma unroll
            for (int j = 0; j < 4; ++j) ((f32x4*)(outp + (size_t)row * D))[lane + 64 * j] = xv[j];
        }
        if (wpre) {
            float s = 0.f;
#pragma unroll
            for (int j = 0; j < 4; ++j) s += (xv[j].x * xv[j].x + xv[j].y * xv[j].y) + (xv[j].z * xv[j].z + xv[j].w * xv[j].w);
            const float rx = rsqrtf(wave_sum(s) * (1.f / D) + EPS);
            f32x4 hv[4];
#pragma unroll
            for (int j = 0; j < 4; ++j) { hv[j] = xv[j] * rx * wpr[j];
                v2u o; o.x = pk2(hv[j].x, hv[j].y); o.y = pk2(hv[j].z, hv[j].w); ((v2u*)(H + (size_t)row * D))[lane + 64 * j] = o; }
            if (gates_l >= 0) {
                f32x4 a0 = {0.f, 0.f, 0.f, 0.f}, a1 = {0.f, 0.f, 0.f, 0.f};
#pragma unroll
                for (int j = 0; j < 4; ++j)
#pragma unroll
                    for (int e = 0; e < 4; ++e) { const float hh = hv[j][e]; const f32x4 w0 = gt[((j * 4 + e) * 2 + 0) * 64 + lane], w1 = gt[((j * 4 + e) * 2 + 1) * 64 + lane]; a0 = a0 + w0 * hh; a1 = a1 + w1 * hh; }
                float s0 = wave_sum(a0.x), s1 = wave_sum(a0.y), s2 = wave_sum(a0.z), s3 = wave_sum(a0.w), s4 = wave_sum(a1.x), s5 = wave_sum(a1.y), s6 = wave_sum(a1.z), s7 = wave_sum(a1.w);
                if (lane < 8) {
                    float v = s0; v = lane == 1 ? s1 : v; v = lane == 2 ? s2 : v; v = lane == 3 ? s3 : v; v = lane == 4 ? s4 : v; v = lane == 5 ? s5 : v; v = lane == 6 ? s6 : v; v = lane == 7 ? s7 : v;
                    float r;
                    if (lane < 4) r = 1.f / (1.f + __expf(-v));
                    else { const int hd = lane - 4; const float t = v + ((const float*)p->dn_dt_bias)[gates_l * 4 + hd]; const float sp = t > 15.f ? t : __logf(1.f + __expf(t)); r = -__expf(((const float*)p->dn_a_log)[gates_l * 4 + hd]) * sp; }
                    G[(size_t)row * 8 + lane] = r;
                }
            }
        }
        }
    }
}

__device__ __forceinline__ void d0_phase(CParams p, const Ctx cx, int l, int wave, int lane) {
    const bf16* A = (const bf16*)(((unsigned char*)p->ws) + WS_AQKV); bf16* Q = (bf16*)(((unsigned char*)p->ws) + WS_QKVN);
    const float* cw = ((const float*)p->dn_conv) + (size_t)l * 4 * 1536;
    const int gw = cx.bx * NWAVES + wave, NGW = gridDim.x * NWAVES;
    (void)gw; (void)NGW;
    for (int j = wave; j < 4 * ((BATCH * 4 * 64 - cx.bx + (int)gridDim.x - 1) / (int)gridDim.x); j += NWAVES) {
        const int un = cx.bx + (int)gridDim.x * (j >> 2), bh = un >> 6, h = bh & 3, m0 = (bh >> 2) * SEQ + (un & 63) * 64 + 16 * (j & 3), pos0 = m0 & (SEQ - 1);
        float w[3][4][2], win[3][3][2];
#pragma unroll
        for (int mt = 0; mt < 3; ++mt) { const int col = mt * 512 + h * 128 + 2 * lane;
#pragma unroll
            for (int j = 0; j < 4; ++j) { w[mt][j][0] = cw[j * 1536 + col]; w[mt][j][1] = cw[j * 1536 + col + 1]; }
#pragma unroll
            for (int k = 0; k < 3; ++k) {
                unsigned u = 0u; if (pos0 - 3 + k >= 0) u = *(const unsigned*)(A + (size_t)(m0 - 3 + k) * 1536 + col);
                win[mt][k][0] = bflo(u); win[mt][k][1] = bfhi(u); } }
        unsigned lu[16][3];
#pragma unroll
        for (int r = 0; r < 16; ++r)
#pragma unroll
            for (int mt = 0; mt < 3; ++mt) lu[r][mt] = *(const unsigned*)(A + (size_t)(m0 + r) * 1536 + mt * 512 + h * 128 + 2 * lane);
#pragma unroll
        for (int r = 0; r < 16; ++r) {
            const int m = m0 + r; float yv[3][2];
#pragma unroll
            for (int mt = 0; mt < 3; ++mt) { const unsigned u = lu[r][mt];
                const float c0 = bflo(u), c1 = bfhi(u);
                const float y0 = w[mt][0][0] * win[mt][0][0] + w[mt][1][0] * win[mt][1][0] + w[mt][2][0] * win[mt][2][0] + w[mt][3][0] * c0;
                const float y1 = w[mt][0][1] * win[mt][0][1] + w[mt][1][1] * win[mt][1][1] + w[mt][2][1] * win[mt][2][1] + w[mt][3][1] * c1;
                win[mt][0][0] = win[mt][1][0]; win[mt][0][1] = win[mt][1][1]; win[mt][1][0] = win[mt][2][0]; win[mt][1][1] = win[mt][2][1]; win[mt][2][0] = c0; win[mt][2][1] = c1;
                yv[mt][0] = silu_f(y0); yv[mt][1] = silu_f(y1); }
            const float sq = wave_sum(yv[0][0] * yv[0][0] + yv[0][1] * yv[0][1]), sk = wave_sum(yv[1][0] * yv[1][0] + yv[1][1] * yv[1][1]);
            const float rq = rsqrtf(sq + EPS) * 0.08838834764831845f, rk = rsqrtf(sk + EPS);
            bf16* o = Q + (size_t)m * 1536 + h * 128 + 2 * lane;
            *(unsigned*)(o) = pk2(yv[0][0] * rq, yv[0][1] * rq); *(unsigned*)(o + 512) = pk2(yv[1][0] * rk, yv[1][1] * rk); *(unsigned*)(o + 1024) = pk2(yv[2][0], yv[2][1]);
        }
    }
    bf16* Bq = (bf16*)(((unsigned char*)p->ws) + WS_BQKV); const float* tab = (const float*)(((unsigned char*)p->ws) + WS_ROPE);
    for (int i = cx.bx * NTHR + cx.tid; i < M * 16; i += gridDim.x * NTHR) {
        const int m = i >> 4, hh = i & 15, pos = m & (SEQ - 1);
        bf16* ptr = Bq + (size_t)m * 1536 + hh * 64;
        const v4u a = *(const v4u*)ptr, b = *(const v4u*)(ptr + 8);
        const f32x4 c0 = *(const f32x4*)(tab + pos * 16), c1 = *(const f32x4*)(tab + pos * 16 + 4), s0 = *(const f32x4*)(tab + pos * 16 + 8), s1 = *(const f32x4*)(tab + pos * 16 + 12);
        const float x1[8] = {bflo(a.x), bfhi(a.x), bflo(a.y), bfhi(a.y), bflo(a.z), bfhi(a.z), bflo(a.w), bfhi(a.w)};
        const float x2[8] = {bflo(b.x), bfhi(b.x), bflo(b.y), bfhi(b.y), bflo(b.z), bfhi(b.z), bflo(b.w), bfhi(b.w)};
        const float cc[8] = {c0.x, c0.y, c0.z, c0.w, c1.x, c1.y, c1.z, c1.w}, ss[8] = {s0.x, s0.y, s0.z, s0.w, s1.x, s1.y, s1.z, s1.w};
        float o1[8], o2[8];
#pragma unroll
        for (int q = 0; q < 8; ++q) { o1[q] = x1[q] * cc[q] - x2[q] * ss[q]; o2[q] = x2[q] * cc[q] + x1[q] * ss[q]; }
        v4u oa, ob; oa.x = pk2(o1[0], o1[1]); oa.y = pk2(o1[2], o1[3]); oa.z = pk2(o1[4], o1[5]); oa.w = pk2(o1[6], o1[7]);
        ob.x = pk2(o2[0], o2[1]); ob.y = pk2(o2[2], o2[3]); ob.z = pk2(o2[4], o2[5]); ob.w = pk2(o2[6], o2[7]);
        *(v4u*)ptr = oa; *(v4u*)(ptr + 8) = ob;
    }
}

__device__ __forceinline__ void scan_naive_unit(CParams p, const Ctx cx, int l, int bh, LAS unsigned char* lds, int wave, int lane) {
    const int b = bh >> 2, h = bh & 3, tid = cx.tid;
    const bf16* Q = (const bf16*)(((unsigned char*)p->ws) + WS_QKVN); const float* G = (const float*)(((unsigned char*)p->ws) + WS_GATES); const bf16* Z = (const bf16*)(((unsigned char*)p->ws) + WS_Z); bf16* MX = (bf16*)((float*)p->out);
    LAS float* obuf = (LAS float*)(lds + 49152); LAS float* gbeta = (LAS float*)(lds + 81920); LAS float* galpha = gbeta + 64;
    const int c16 = lane & 15, part = lane >> 4, c = 16 * wave + c16;
    float S[32];
#pragma unroll
    for (int i = 0; i < 32; ++i) S[i] = 0.f;
    for (int ch = 0; ch < SEQ / 64; ++ch) {
        const int mbase = b * SEQ + ch * 64;
        __syncthreads();
#pragma unroll
        for (int r = 0; r < 6; ++r) { const int idx = tid + NTHR * r, mat = idx >> 10, rem = idx & 1023, tk = rem >> 4, seg = rem & 15;
            const v4u v = *(const v4u*)(Q + (size_t)(mbase + tk) * 1536 + mat * 512 + h * 128 + seg * 8);
            *(LAS v4u*)(lds + mat * 16384 + tk * 256 + seg * 16) = v; }
        if (tid < 64) { gbeta[tid] = G[(size_t)(mbase + tid) * 8 + h]; galpha[tid] = __expf(G[(size_t)(mbase + tid) * 8 + 4 + h]); }
        __syncthreads();
        for (int tk = 0; tk < 64; ++tk) {
            const float beta = gbeta[tk], alpha = galpha[tk];
            float kf[32], acc = 0.f;
#pragma unroll
            for (int q4 = 0; q4 < 4; ++q4) { const v4u kv = *(const LAS v4u*)(lds + 16384 + tk * 256 + part * 64 + q4 * 16);
                kf[8 * q4 + 0] = bflo(kv.x); kf[8 * q4 + 1] = bfhi(kv.x); kf[8 * q4 + 2] = bflo(kv.y); kf[8 * q4 + 3] = bfhi(kv.y);
                kf[8 * q4 + 4] = bflo(kv.z); kf[8 * q4 + 5] = bfhi(kv.z); kf[8 * q4 + 6] = bflo(kv.w); kf[8 * q4 + 7] = bfhi(kv.w); }
#pragma unroll
            for (int i = 0; i < 32; ++i) acc += kf[i] * S[i];
            acc += shflx(acc, 16, lane); acc += shflx(acc, 32, lane);
            const unsigned short vb = *(const LAS unsigned short*)(lds + 32768 + tk * 256 + c * 2);
            const float vn = beta * (__uint_as_float((unsigned)vb << 16) - alpha * acc);
            float o = 0.f;
#pragma unroll
            for (int q4 = 0; q4 < 4; ++q4) { const v4u qv = *(const LAS v4u*)(lds + tk * 256 + part * 64 + q4 * 16);
                const float qf[8] = {bflo(qv.x), bfhi(qv.x), bflo(qv.y), bfhi(qv.y), bflo(qv.z), bfhi(qv.z), bflo(qv.w), bfhi(qv.w)};
#pragma unroll
                for (int e = 0; e < 8; ++e) { const int i = 8 * q4 + e; S[i] = alpha * S[i] + kf[i] * vn; o += qf[e] * S[i]; } }
            o += shflx(o, 16, lane); o += shflx(o, 32, lane);
            if (part == 0) obuf[tk * 128 + c] = o;
        }
        __syncthreads();
        {
            const int tk = tid >> 3, sub = tid & 7, m = mbase + tk;
            float ov[16], ss = 0.f;
#pragma unroll
            for (int q4 = 0; q4 < 4; ++q4) { const f32x4 t = *(const LAS f32x4*)(obuf + tk * 128 + sub * 16 + q4 * 4); ov[4 * q4] = t.x; ov[4 * q4 + 1] = t.y; ov[4 * q4 + 2] = t.z; ov[4 * q4 + 3] = t.w; }
#pragma unroll
            for (int e = 0; e < 16; ++e) ss += ov[e] * ov[e];
            ss += DPP_F(ss, 0xB1); ss += DPP_F(ss, 0x4E); ss += DPP_F(ss, 0x141);
            const float rstd = rsqrtf(ss * (1.f / 128.f) + EPS);
            const v4u z0 = *(const v4u*)(Z + (size_t)m * 512 + h * 128 + sub * 16), z1 = *(const v4u*)(Z + (size_t)m * 512 + h * 128 + sub * 16 + 8);
            const float zf[16] = {bflo(z0.x), bfhi(z0.x), bflo(z0.y), bfhi(z0.y), bflo(z0.z), bfhi(z0.z), bflo(z0.w), bfhi(z0.w), bflo(z1.x), bfhi(z1.x), bflo(z1.y), bfhi(z1.y), bflo(z1.z), bfhi(z1.z), bflo(z1.w), bfhi(z1.w)};
            const float* wn = ((const float*)p->dn_out_norm) + l * 128 + sub * 16;
            float r[16];
#pragma unroll
            for (int e = 0; e < 16; ++e) r[e] = ov[e] * rstd * wn[e] * silu_f(zf[e]);
            v4u o0, o1; o0.x = pk2(r[0], r[1]); o0.y = pk2(r[2], r[3]); o0.z = pk2(r[4], r[5]); o0.w = pk2(r[6], r[7]); o1.x = pk2(r[8], r[9]); o1.y = pk2(r[10], r[11]); o1.z = pk2(r[12], r[13]); o1.w = pk2(r[14], r[15]);
            bf16* dst = MX + (size_t)m * 1024 + h * 128 + sub * 16; *(v4u*)dst = o0; *(v4u*)(dst + 8) = o1;
        }
    }
}

__device__ __forceinline__ void attn_naive_item(CParams p, int item) {
    const int m = item >> 3, hd = item & 7, pos = m & (SEQ - 1);
    const bf16* Bq = (const bf16*)(((unsigned char*)p->ws) + WS_BQKV); bf16* MX = (bf16*)((float*)p->out);
    float q[64], acc[64];
    { const bf16* qp = Bq + (size_t)m * 1536 + hd * 64;
#pragma unroll
      for (int s = 0; s < 8; ++s) { const v4u v = *(const v4u*)(qp + 8 * s); q[8 * s] = bflo(v.x); q[8 * s + 1] = bfhi(v.x); q[8 * s + 2] = bflo(v.y); q[8 * s + 3] = bfhi(v.y); q[8 * s + 4] = bflo(v.z); q[8 * s + 5] = bfhi(v.z); q[8 * s + 6] = bflo(v.w); q[8 * s + 7] = bfhi(v.w); } }
#pragma unroll
    for (int i = 0; i < 64; ++i) acc[i] = 0.f;
    float mx = -1e30f, lsum = 0.f;
    for (int g = 0; g < 3; ++g) {
        const int d = g == 0 ? 1 : (g == 1 ? 4 : 16);
        for (int j = 0; j <= 128; ++j) {
            if (pos - j * d < 0) break;
            const bf16* kp = Bq + (size_t)(m - j * d) * 1536 + 512 + hd * 64; const bf16* vp = kp + 512;
            float s = 0.f;
#pragma unroll
            for (int t = 0; t < 8; ++t) { const v4u v = *(const v4u*)(kp + 8 * t);
                s += q[8 * t] * bflo(v.x) + q[8 * t + 1] * bfhi(v.x) + q[8 * t + 2] * bflo(v.y) + q[8 * t + 3] * bfhi(v.y) + q[8 * t + 4] * bflo(v.z) + q[8 * t + 5] * bfhi(v.z) + q[8 * t + 6] * bflo(v.w) + q[8 * t + 7] * bfhi(v.w); }
            s *= 0.125f;
            const float mn = fmaxf(mx, s), sc = __expf(mx - mn), pe = __expf(s - mn);
            lsum = lsum * sc + pe; mx = mn;
#pragma unroll
            for (int t = 0; t < 8; ++t) { const v4u v = *(const v4u*)(vp + 8 * t);
                acc[8 * t] = acc[8 * t] * sc + pe * bflo(v.x); acc[8 * t + 1] = acc[8 * t + 1] * sc + pe * bfhi(v.x); acc[8 * t + 2] = acc[8 * t + 2] * sc + pe * bflo(v.y); acc[8 * t + 3] = acc[8 * t + 3] * sc + pe * bfhi(v.y);
                acc[8 * t + 4] = acc[8 * t + 4] * sc + pe * bflo(v.z); acc[8 * t + 5] = acc[8 * t + 5] * sc + pe * bfhi(v.z); acc[8 * t + 6] = acc[8 * t + 6] * sc + pe * bflo(v.w); acc[8 * t + 7] = acc[8 * t + 7] * sc + pe * bfhi(v.w); }
        }
    }
    const float inv = 1.f / lsum; bf16* dst = MX + (size_t)m * 1024 + 512 + hd * 64;
#pragma unroll
    for (int s = 0; s < 8; ++s) { v4u o; o.x = pk2(acc[8 * s] * inv, acc[8 * s + 1] * inv); o.y = pk2(acc[8 * s + 2] * inv, acc[8 * s + 3] * inv); o.z = pk2(acc[8 * s + 4] * inv, acc[8 * s + 5] * inv); o.w = pk2(acc[8 * s + 6] * inv, acc[8 * s + 7] * inv); *(v4u*)(dst + 8 * s) = o; }
}


__device__ __forceinline__ unsigned pkhi(float lo, float hi) { return __builtin_amdgcn_perm(__float_as_uint(hi), __float_as_uint(lo), 0x07060302u); }
#define MFMA16(a, b, c) __builtin_amdgcn_mfma_f32_16x16x32_bf16((a), (b), (c), 0, 0, 0)
struct ATile { int tok0, dstep, C, valid; };
__device__ __forceinline__ ATile attn_tile(int u, int r, int T0, int fr) {
    int d, kt, roff, off, step, tb;
    if (u < 9) { d = 16; kt = u; roff = r; off = 0; step = 1; tb = T0 >> 4; }
    else if (u < 21) { d = 4; kt = u - 9; roff = r & 3; off = r >> 2; step = 4; tb = T0 >> 2; }
    else { d = 1; kt = u - 21; roff = 0; off = r; step = 16; tb = T0; }
    const int base = tb - 128 + 16 * kt;
    ATile t; t.valid = (base >= 0) && (u < 45); const int bb = t.valid ? base : 0;
    t.tok0 = roff + d * bb; t.dstep = d; t.C = off + step * fr + 128 - 16 * kt;
    return t;
}
struct APair { ATile t[2]; int dC; int act; };
__device__ __forceinline__ APair attn_pair(int pr, int w8, int T0, int fr) {
    APair q;
    if (pr < 5) { q.t[0] = attn_tile(2 * pr, w8, T0, fr); q.t[1] = attn_tile(2 * pr + 1 < 9 ? 2 * pr + 1 : 45, w8, T0, fr); q.dC = 0; q.act = 1; }
    else if (pr < 10) { const int k2 = 2 * (pr - 5); q.t[0] = attn_tile(k2, w8 + 8, T0, fr); q.t[1] = attn_tile(k2 + 1 < 9 ? k2 + 1 : 45, w8 + 8, T0, fr); q.dC = 0; q.act = 2; }
    else if (pr < 16) { const int k2 = 9 + 2 * (pr - 10); q.t[0] = attn_tile(k2, w8, T0, fr); q.t[1] = attn_tile(k2 + 1, w8, T0, fr); q.dC = 2; q.act = 3; }
    else { const int k2 = 21 + 2 * (pr - 16); q.t[0] = attn_tile(k2, w8, T0, fr); q.t[1] = attn_tile(k2 + 1, w8, T0, fr); q.dC = 8; q.act = 3; }
    return q;
}
__device__ __forceinline__ void attn_softmax_pv(const bf16x8 (&Kc)[2][2], const bf16x8 (&Qf)[2], const APair& pc, int dC, const bf16x8 (&Vt)[4], float& mrun, float& lrun, f32x4 (&O)[4], int fq, int lane) {
    const float SC = 0.125f * 1.4426950408889634f;
    f32x4 sc[2]; float pm = -3e30f;
#pragma unroll
    for (int h2 = 0; h2 < 2; ++h2) {
        f32x4 z = {0.f, 0.f, 0.f, 0.f};
        z = MFMA16(Kc[h2][0], Qf[0], z); z = MFMA16(Kc[h2][1], Qf[1], z);
        const int c4 = pc.t[h2].C + dC - 4 * fq;
#pragma unroll
        for (int j = 0; j < 4; ++j) { const bool ok = pc.t[h2].valid && ((unsigned)(c4 - j) <= 128u); z[j] = ok ? z[j] * SC : -3e30f; pm = fmaxf(pm, z[j]); }
        sc[h2] = z;
    }
    pm = fmaxf(pm, shflx(pm, 16, lane)); pm = fmaxf(pm, shflx(pm, 32, lane));
    const float mnew = fmaxf(mrun, pm), alpha = __builtin_amdgcn_exp2f(mrun - mnew); mrun = mnew;
    float ps = 0.f;
#pragma unroll
    for (int h2 = 0; h2 < 2; ++h2)
#pragma unroll
        for (int j = 0; j < 4; ++j) { sc[h2][j] = __builtin_amdgcn_exp2f(sc[h2][j] - mnew); ps += sc[h2][j]; }
    lrun = lrun * alpha + ps;
    v4u pp; pp.x = cvtpk(sc[0][0], sc[0][1]); pp.y = cvtpk(sc[0][2], sc[0][3]); pp.z = cvtpk(sc[1][0], sc[1][1]); pp.w = cvtpk(sc[1][2], sc[1][3]);
    const bf16x8 Pp = __builtin_bit_cast(bf16x8, pp);
#pragma unroll
    for (int mt = 0; mt < 4; ++mt) { O[mt] = O[mt] * alpha; O[mt] = MFMA16(Vt[mt], Pp, O[mt]); }
}
__device__ __forceinline__ void attn_mfma_unit(CParams p, int unit, int lane, LAS unsigned char* kvl) {
    const int w8 = unit & 7, I = unit >> 9, hd = (unit >> 3) & 7, b = (unit >> 6) & 7, T0 = I * 256, fr = lane & 15, fq = lane >> 4;
    const bf16* Bq = (const bf16*)(((unsigned char*)p->ws) + WS_BQKV); bf16* MX = (bf16*)((float*)p->out);
    const bf16* rowb = Bq + (size_t)b * SEQ * 1536 + hd * 64 + 8 * fq;
    const int qtokA = T0 + w8 + 16 * fr, qtokB = qtokA + 8;
    bf16x8 Qa[2], Qb[2];
    Qa[0] = *(const bf16x8*)(rowb + (size_t)qtokA * 1536); Qa[1] = *(const bf16x8*)(rowb + (size_t)qtokA * 1536 + 32);
    Qb[0] = *(const bf16x8*)(rowb + (size_t)qtokB * 1536); Qb[1] = *(const bf16x8*)(rowb + (size_t)qtokB * 1536 + 32);
    bf16x8 Sel[2];
#pragma unroll
    for (int c = 0; c < 2; ++c)
#pragma unroll
        for (int j = 0; j < 8; ++j) Sel[c][j] = (8 * fq + j == 16 * c + fr) ? (short)0x3F80 : (short)0;
    f32x4 Oa[4], Ob[4];
#pragma unroll
    for (int mt = 0; mt < 4; ++mt) { Oa[mt] = (f32x4){0.f, 0.f, 0.f, 0.f}; Ob[mt] = (f32x4){0.f, 0.f, 0.f, 0.f}; }
    float mA = -1e30f, lA = 0.f, mB = -1e30f, lB = 0.f;
    bf16x8 Kc[2][2], Vc[2][2], Kn[2][2], Vn[2][2];
    APair pc = attn_pair(0, w8, T0, fr), pn = pc;
#pragma unroll
    for (int h2 = 0; h2 < 2; ++h2) { const bf16* kp = rowb + (size_t)(pc.t[h2].tok0 + pc.t[h2].dstep * fr) * 1536 + 512;
        Kc[h2][0] = *(const bf16x8*)kp; Kc[h2][1] = *(const bf16x8*)(kp + 32); Vc[h2][0] = *(const bf16x8*)(kp + 512); Vc[h2][1] = *(const bf16x8*)(kp + 544); }
#pragma unroll 1
    for (int pr = 0; pr < 28; ++pr) {
        if (pr + 1 < 16) { pn = attn_pair(pr + 1, w8, T0, fr);
#pragma unroll
            for (int h2 = 0; h2 < 2; ++h2) { const bf16* kp = rowb + (size_t)(pn.t[h2].tok0 + pn.t[h2].dstep * fr) * 1536 + 512;
                Kn[h2][0] = *(const bf16x8*)kp; Kn[h2][1] = *(const bf16x8*)(kp + 32); Vn[h2][0] = *(const bf16x8*)(kp + 512); Vn[h2][1] = *(const bf16x8*)(kp + 544); }
        } else if (pr + 1 < 28) { pn = attn_pair(pr + 1, w8, T0, fr);
#pragma unroll
            for (int h2 = 0; h2 < 2; ++h2) { LAS unsigned char* kp = kvl + (16 * (2 * (pr + 1 - 16) + h2) + fr) * 272 + fq * 16;
                Kn[h2][0] = *(const LAS bf16x8*)kp; Kn[h2][1] = *(const LAS bf16x8*)(kp + 64); Vn[h2][0] = *(const LAS bf16x8*)(kp + 128); Vn[h2][1] = *(const LAS bf16x8*)(kp + 192); }
        }
        if (pc.t[0].valid | pc.t[1].valid) {
        bf16x8 Vt[4];
#pragma unroll
        for (int mt = 0; mt < 4; ++mt) {
            const f32x4 z = {0.f, 0.f, 0.f, 0.f};
            const f32x4 va = MFMA16(Vc[0][mt >> 1], Sel[mt & 1], z), vb = MFMA16(Vc[1][mt >> 1], Sel[mt & 1], z);
            v4u vp; vp.x = pkhi(va[0], va[1]); vp.y = pkhi(va[2], va[3]); vp.z = pkhi(vb[0], vb[1]); vp.w = pkhi(vb[2], vb[3]);
            Vt[mt] = __builtin_bit_cast(bf16x8, vp);
        }
        if (pc.act & 1) attn_softmax_pv(Kc, Qa, pc, 0, Vt, mA, lA, Oa, fq, lane);
        if (pc.act & 2) attn_softmax_pv(Kc, Qb, pc, pc.dC, Vt, mB, lB, Ob, fq, lane);
        }
        pc = pn;
#pragma unroll
        for (int h2 = 0; h2 < 2; ++h2) { Kc[h2][0] = Kn[h2][0]; Kc[h2][1] = Kn[h2][1]; Vc[h2][0] = Vn[h2][0]; Vc[h2][1] = Vn[h2][1]; }
    }
    lA += shflx(lA, 16, lane); lA += shflx(lA, 32, lane); lB += shflx(lB, 16, lane); lB += shflx(lB, 32, lane);
    const float ia = 1.f / lA, ib = 1.f / lB;
    bf16* dA = MX + (size_t)(b * SEQ + qtokA) * 1024 + 512 + hd * 64 + 4 * fq; bf16* dB = dA + (size_t)8 * 1024;
#pragma unroll
    for (int mt = 0; mt < 4; ++mt) { v2u o; o.x = cvtpk(Oa[mt][0] * ia, Oa[mt][1] * ia); o.y = cvtpk(Oa[mt][2] * ia, Oa[mt][3] * ia); *(v2u*)(dA + 16 * mt) = o;
        v2u o2; o2.x = cvtpk(Ob[mt][0] * ib, Ob[mt][1] * ib); o2.y = cvtpk(Ob[mt][2] * ib, Ob[mt][3] * ib); *(v2u*)(dB + 16 * mt) = o2; }
}


__device__ __forceinline__ void attn_stage(CParams p, const Ctx cx, int bu, LAS unsigned char* kvl) {
    const int I = bu >> 6, hd = bu & 7, b = (bu >> 3) & 7, T0 = I * 256;
    const bf16* Bq = (const bf16*)(((unsigned char*)p->ws) + WS_BQKV) + (size_t)b * SEQ * 1536 + 512 + hd * 64;
    __syncthreads();
    v4u st[12];
#pragma unroll
    for (int r = 0; r < 12; ++r) { const int idx = cx.tid + NTHR * r, row = idx >> 4, seg = idx & 15, tok = T0 - 128 + row;
        st[r] = (v4u){0u, 0u, 0u, 0u};
        if (tok >= 0) st[r] = *(const v4u*)(Bq + (size_t)tok * 1536 + (seg < 8 ? seg * 8 : 512 + (seg - 8) * 8)); }
#pragma unroll
    for (int r = 0; r < 12; ++r) { const int idx = cx.tid + NTHR * r; *(LAS v4u*)(kvl + (idx >> 4) * 272 + (idx & 15) * 16) = st[r]; }
    __syncthreads();
}

constexpr size_t WS_UT = 224 * MiB, WS_WM = 256 * MiB, WS_KT = 288 * MiB, WS_QKM = 416 * MiB, WS_GC = 432 * MiB, WS_ORAW = 440 * MiB;
#define D1_ROWPTR(un_, r_) (((const bf16*)(((unsigned char*)p->ws) + WS_QKVN)) + (size_t)((((un_) >> 6) >> 2) * SEQ + ((un_) & 63) * 64 + (((cx.tid + NTHR * (r_)) & 1023) >> 4)) * 1536 + ((cx.tid + NTHR * (r_)) >> 10) * 512 + (((un_) >> 6) & 3) * 128 + ((cx.tid + NTHR * (r_)) & 15) * 8)
__device__ __forceinline__ void d1_unit(CParams p, const Ctx cx, int unit, int next_unit, v4u& pf0, v4u& pf1, v4u& pf2, v4u& pf3, v4u& pf4, v4u& pf5, LAS unsigned char* lds, int wave, int lane) {
    const int tid = cx.tid, c = unit & 63, bh = unit >> 6, b = bh >> 2, h = bh & 3, mbase = b * SEQ + c * 64, fr = lane & 15, fq = lane >> 4;
    const bf16* Q = (const bf16*)(((unsigned char*)p->ws) + WS_QKVN); const float* Gt = (const float*)(((unsigned char*)p->ws) + WS_GATES);
    LAS unsigned char* qs = lds; LAS unsigned char* ks = lds + 17408; LAS unsigned char* vs = lds + 34816;
    LAS float* Am = (LAS float*)(lds + 51200); LAS float* gG = (LAS float*)(lds + 67584); LAS float* gB = gG + 64; LAS float* gE = gG + 128;
    float g = 0.f, be = 0.f;
    if (tid < 64) { g = Gt[(size_t)(mbase + tid) * 8 + 4 + h]; be = Gt[(size_t)(mbase + tid) * 8 + h]; }
    __syncthreads();
    { const v4u pv[6] = {pf0, pf1, pf2, pf3, pf4, pf5};
#pragma unroll
      for (int r = 0; r < 6; ++r) { const int idx = tid + NTHR * r, mat = idx >> 10, rem = idx & 1023, tk = rem >> 4, seg = rem & 15;
        *(LAS v4u*)(lds + (mat == 2 ? 34816 + tk * 256 : mat * 17408 + tk * 272) + seg * 16) = pv[r]; } }
    if (tid < 64) {
#pragma unroll
        for (int o = 1; o < 64; o <<= 1) { const float t = shflx(g, 0, lane - o < 0 ? lane : lane - o); if (lane >= o) g += t; }
        const float glast = __builtin_bit_cast(float, __builtin_amdgcn_readlane(__builtin_bit_cast(int, g), 63));
        gG[tid] = g; gB[tid] = be; gE[tid] = __expf(g);
        float* gc = (float*)(((unsigned char*)p->ws) + WS_GC) + (size_t)unit * 128; gc[tid] = __expf(g); gc[64 + tid] = __expf(glast - g);
    }
    __syncthreads();
    {
        const int mat = wave >> 2, tm = wave & 3;
        LAS unsigned char* asrc = (mat ? qs : ks) + (16 * tm + fr) * 272 + fq * 16;
        bf16x8 af[4];
#pragma unroll
        for (int s4 = 0; s4 < 4; ++s4) af[s4] = *(const LAS bf16x8*)(asrc + s4 * 64);
        float Gi[4], Bi[4];
#pragma unroll
        for (int j = 0; j < 4; ++j) { Gi[j] = gG[16 * tm + 4 * fq + j]; Bi[j] = gB[16 * tm + 4 * fq + j]; }
#pragma unroll
        for (int tn = 0; tn < 4; ++tn) {
            f32x4 acc = {0.f, 0.f, 0.f, 0.f};
#pragma unroll
            for (int s4 = 0; s4 < 4; ++s4) { const bf16x8 bfr = *(const LAS bf16x8*)(ks + (16 * tn + fr) * 272 + fq * 16 + s4 * 64); acc = MFMA16(af[s4], bfr, acc); }
            const int jj = 16 * tn + fr; const float Gj = gG[jj];
#pragma unroll
            for (int j = 0; j < 4; ++j) { const int ii = 16 * tm + 4 * fq + j; const float e = __expf(fminf(Gi[j] - Gj, 0.f));
                if (mat == 0) Am[jj * 64 + ii] = (ii > jj) ? Bi[j] * acc[j] * e : 0.f;
                else *(LAS unsigned short*)(lds + 134144 + (ii * 64 + jj) * 2) = (unsigned short)f2bf((ii >= jj) ? acc[j] * e : 0.f); }
        }
    }
    __syncthreads();
    if (tid < 256) {
        const int cc = tid & 127; const bool isw = tid >= 128;
        LAS float* xs = (LAS float*)(lds + 68608);
#pragma unroll 1
        for (int blk = 0; blk < 4; ++blk) {
            float acc[16];
#pragma unroll
            for (int r = 0; r < 16; ++r) { const int i = 16 * blk + r;
                const unsigned short raw = isw ? *(const LAS unsigned short*)(ks + i * 272 + cc * 2) : *(const LAS unsigned short*)(vs + i * 256 + cc * 2);
                float a = __uint_as_float((unsigned)raw << 16) * gB[i]; if (isw) a *= gE[i]; acc[r] = a; }
#pragma unroll 4
            for (int j = 0; j < 16 * blk; ++j) { const float xj = xs[j * 256 + tid]; const LAS f32x4* at = (const LAS f32x4*)(Am + j * 64 + 16 * blk);
#pragma unroll
                for (int q = 0; q < 4; ++q) { const f32x4 t = at[q]; acc[4 * q] -= t.x * xj; acc[4 * q + 1] -= t.y * xj; acc[4 * q + 2] -= t.z * xj; acc[4 * q + 3] -= t.w * xj; } }
#pragma unroll
            for (int r2 = 0; r2 < 15; ++r2) { const float xr = acc[r2]; const LAS float* row = Am + (16 * blk + r2) * 64 + 16 * blk;
#pragma unroll
                for (int q = (r2 + 1) / 4; q < 4; ++q) { const f32x4 t = *(const LAS f32x4*)(row + 4 * q);
                    if (4 * q + 0 > r2) acc[4 * q + 0] -= t.x * xr; if (4 * q + 1 > r2) acc[4 * q + 1] -= t.y * xr; if (4 * q + 2 > r2) acc[4 * q + 2] -= t.z * xr; if (4 * q + 3 > r2) acc[4 * q + 3] -= t.w * xr; } }
#pragma unroll
            for (int r = 0; r < 16; ++r) xs[(16 * blk + r) * 256 + tid] = acc[r];
        }
    } else {
        const int t2 = tid - 256, dk = t2 & 127, g2 = t2 >> 7; bf16* kt = (bf16*)(((unsigned char*)p->ws) + WS_KT) + (size_t)unit * 8192 + dk * 64 + 32 * g2;
#pragma unroll
        for (int q8 = 0; q8 < 4; ++q8) { unsigned short e[8];
#pragma unroll
            for (int t = 0; t < 8; ++t) e[t] = *(const LAS unsigned short*)(ks + (32 * g2 + 8 * q8 + t) * 272 + dk * 2);
            v4u o; o.x = e[0] | ((unsigned)e[1] << 16); o.y = e[2] | ((unsigned)e[3] << 16); o.z = e[4] | ((unsigned)e[5] << 16); o.w = e[6] | ((unsigned)e[7] << 16); *(v4u*)(kt + 8 * q8) = o; }
    }
    if (next_unit >= 0) { pf0 = *(const v4u*)D1_ROWPTR(next_unit, 0); pf1 = *(const v4u*)D1_ROWPTR(next_unit, 1); pf2 = *(const v4u*)D1_ROWPTR(next_unit, 2); pf3 = *(const v4u*)D1_ROWPTR(next_unit, 3); pf4 = *(const v4u*)D1_ROWPTR(next_unit, 4); pf5 = *(const v4u*)D1_ROWPTR(next_unit, 5); }
    __syncthreads();
    {
        const LAS float* xs = (const LAS float*)(lds + 68608);
        bf16* wm = (bf16*)(((unsigned char*)p->ws) + WS_WM) + (size_t)unit * 8192; bf16* ut = (bf16*)(((unsigned char*)p->ws) + WS_UT) + (size_t)unit * 8192;
#pragma unroll
        for (int r2 = 0; r2 < 2; ++r2) { const int idx = tid + NTHR * r2, i = idx >> 4, seg = idx & 15;
            const f32x4 a0 = *(const LAS f32x4*)(xs + i * 256 + 128 + seg * 8), a1 = *(const LAS f32x4*)(xs + i * 256 + 128 + seg * 8 + 4);
            v4u o; o.x = cvtpk(a0.x, a0.y); o.y = cvtpk(a0.z, a0.w); o.z = cvtpk(a1.x, a1.y); o.w = cvtpk(a1.z, a1.w); *(v4u*)(wm + i * 128 + seg * 8) = o; }
#pragma unroll
        for (int r2 = 0; r2 < 2; ++r2) { const int idx = tid + NTHR * r2, dv = idx >> 3, seg = idx & 7; float e[8];
#pragma unroll
            for (int t = 0; t < 8; ++t) e[t] = xs[(seg * 8 + t) * 256 + dv];
            v4u o; o.x = cvtpk(e[0], e[1]); o.y = cvtpk(e[2], e[3]); o.z = cvtpk(e[4], e[5]); o.w = cvtpk(e[6], e[7]); *(v4u*)(ut + dv * 64 + seg * 8) = o; }
        { const v4u q = *(const LAS v4u*)(lds + 134144 + tid * 16); *(v4u*)((bf16*)(((unsigned char*)p->ws) + WS_QKM) + (size_t)unit * 4096 + tid * 8) = q; }
    }
}

__device__ __forceinline__ bf16x8 ldfrag8(LAS unsigned char* pa) { const v2u a = *(const LAS v2u*)pa, b = *(const LAS v2u*)(pa + 32); v4u r; r.x = a.x; r.y = a.y; r.z = b.x; r.w = b.y; return __builtin_bit_cast(bf16x8, r); }
__device__ __forceinline__ void scan_chunked_unit(CParams p, const Ctx cx, int l, int bh, LAS unsigned char* lds, int wave, int lane) {
    const int tid = cx.tid, b = bh >> 2, h = bh & 3, fr = lane & 15, fq = lane >> 4;
    const bf16* Q = (const bf16*)(((unsigned char*)p->ws) + WS_QKVN); bf16* OR = (bf16*)(((unsigned char*)p->ws) + WS_ORAW);
    const bf16* Wm = (const bf16*)(((unsigned char*)p->ws) + WS_WM); const bf16* KT = (const bf16*)(((unsigned char*)p->ws) + WS_KT); const bf16* UT = (const bf16*)(((unsigned char*)p->ws) + WS_UT); const bf16* QKm = (const bf16*)(((unsigned char*)p->ws) + WS_QKM);
    const float* Gc = (const float*)(((unsigned char*)p->ws) + WS_GC);
    constexpr int BUF = 61440, O_W = 0, O_Q = 17408, O_KT = 34816, O_QK = 52224, O_G = 2 * BUF, O_OT = 2 * BUF + 1024;
    f32x4 Sacc[8];
#pragma unroll
    for (int dt = 0; dt < 8; ++dt) Sacc[dt] = (f32x4){0.f, 0.f, 0.f, 0.f};
    v4u st[7]; float gst = 0.f;
    __syncthreads();
#define SCAN_LOAD(ch) do { const size_t un = (size_t)bh * 64 + (ch); const int mb = b * SEQ + (ch) * 64; \
        _Pragma("unroll") for (int r = 0; r < 7; ++r) { const int idx = tid + NTHR * r; const bf16* src; \
            if (r < 2) src = Wm + un * 8192 + (idx >> 4) * 128 + (idx & 15) * 8; \
            else if (r < 4) src = Q + (size_t)(mb + ((idx - 1024) >> 4)) * 1536 + h * 128 + (idx & 15) * 8; \
            else if (r < 6) src = KT + un * 8192 + ((idx - 2048) >> 3) * 64 + (idx & 7) * 8; \
            else src = QKm + un * 4096 + ((idx - 3072) >> 3) * 64 + (idx & 7) * 8; \
            st[r] = *(const v4u*)src; } \
        if (tid < 128) gst = Gc[un * 128 + tid]; } while (0)
#define SCAN_STORE(par) do { LAS unsigned char* bb = lds + (par) * BUF; \
        _Pragma("unroll") for (int r = 0; r < 7; ++r) { const int idx = tid + NTHR * r; int off; \
            if (r < 2) off = O_W + (idx >> 4) * 272 + (idx & 15) * 16; \
            else if (r < 4) off = O_Q + ((idx - 1024) >> 4) * 272 + (idx & 15) * 16; \
            else if (r < 6) off = O_KT + ((idx - 2048) >> 3) * 136 + (idx & 7) * 16; \
            else off = O_QK + ((idx - 3072) >> 3) * 136 + (idx & 7) * 16; \
            *(LAS v4u*)(bb + off) = st[r]; } \
        if (tid < 128) ((LAS float*)(lds + O_G))[(par) * 128 + tid] = gst; } while (0)
    SCAN_LOAD(0); SCAN_STORE(0);
    v2u uun[4];
#pragma unroll
    for (int tm = 0; tm < 4; ++tm) uun[tm] = *(const v2u*)(UT + (size_t)bh * 64 * 8192 + (16 * wave + fr) * 64 + 16 * tm + 4 * fq);
    const int ftk = tid >> 3, fsub = tid & 7;
    __syncthreads();
    for (int ch = 0; ch < SEQ / 64; ++ch) {
        const int par = ch & 1, mb = b * SEQ + ch * 64; const size_t un = (size_t)bh * 64 + ch;
        LAS unsigned char* bb = lds + par * BUF;
        if (ch + 1 < SEQ / 64) SCAN_LOAD(ch + 1);
        v2u uu[4];
#pragma unroll
        for (int tm = 0; tm < 4; ++tm) uu[tm] = uun[tm];
        if (ch + 1 < SEQ / 64) {
#pragma unroll
            for (int tm = 0; tm < 4; ++tm) uun[tm] = *(const v2u*)(UT + (un + 1) * 8192 + (16 * wave + fr) * 64 + 16 * tm + 4 * fq);
        }
        const LAS float* Gs = (const LAS float*)(lds + O_G) + par * 128;
        const float dc = Gs[63];
        bf16x8 Sb[4];
#pragma unroll
        for (int s4 = 0; s4 < 4; ++s4) { v4u t; t.x = cvtpk(Sacc[2 * s4][0], Sacc[2 * s4][1]); t.y = cvtpk(Sacc[2 * s4][2], Sacc[2 * s4][3]); t.z = cvtpk(Sacc[2 * s4 + 1][0], Sacc[2 * s4 + 1][1]); t.w = cvtpk(Sacc[2 * s4 + 1][2], Sacc[2 * s4 + 1][3]); Sb[s4] = __builtin_bit_cast(bf16x8, t); }
        f32x4 VN[4], OO[4];
#pragma unroll
        for (int tm = 0; tm < 4; ++tm) {
            f32x4 ws_ = {0.f, 0.f, 0.f, 0.f}, qs_ = {0.f, 0.f, 0.f, 0.f};
#pragma unroll
            for (int s4 = 0; s4 < 4; ++s4) { ws_ = MFMA16(ldfrag8(bb + O_W + (16 * tm + fr) * 272 + 64 * s4 + 8 * fq), Sb[s4], ws_);
                                              qs_ = MFMA16(ldfrag8(bb + O_Q + (16 * tm + fr) * 272 + 64 * s4 + 8 * fq), Sb[s4], qs_); }
            const float u0 = bflo(uu[tm].x), u1 = bfhi(uu[tm].x), u2 = bflo(uu[tm].y), u3 = bfhi(uu[tm].y);
            VN[tm] = (f32x4){u0 - ws_[0], u1 - ws_[1], u2 - ws_[2], u3 - ws_[3]};
#pragma unroll
            for (int j = 0; j < 4; ++j) OO[tm][j] = qs_[j] * Gs[16 * tm + 4 * fq + j];
        }
        bf16x8 Vb[2], Vd[2];
#pragma unroll
        for (int s2 = 0; s2 < 2; ++s2) {
            v4u t; t.x = cvtpk(VN[2 * s2][0], VN[2 * s2][1]); t.y = cvtpk(VN[2 * s2][2], VN[2 * s2][3]); t.z = cvtpk(VN[2 * s2 + 1][0], VN[2 * s2 + 1][1]); t.w = cvtpk(VN[2 * s2 + 1][2], VN[2 * s2 + 1][3]); Vb[s2] = __builtin_bit_cast(bf16x8, t);
            float e[8];
#pragma unroll
            for (int j = 0; j < 8; ++j) e[j] = Gs[64 + 16 * (2 * s2 + (j >> 2)) + 4 * fq + (j & 3)];
            v4u d; d.x = cvtpk(VN[2 * s2][0] * e[0], VN[2 * s2][1] * e[1]); d.y = cvtpk(VN[2 * s2][2] * e[2], VN[2 * s2][3] * e[3]); d.z = cvtpk(VN[2 * s2 + 1][0] * e[4], VN[2 * s2 + 1][1] * e[5]); d.w = cvtpk(VN[2 * s2 + 1][2] * e[6], VN[2 * s2 + 1][3] * e[7]); Vd[s2] = __builtin_bit_cast(bf16x8, d);
        }
#pragma unroll
        for (int tm = 0; tm < 4; ++tm)
#pragma unroll
            for (int s2 = 0; s2 < 2; ++s2) OO[tm] = MFMA16(ldfrag8(bb + O_QK + (16 * tm + fr) * 136 + 64 * s2 + 8 * fq), Vb[s2], OO[tm]);
#pragma unroll
        for (int dt = 0; dt < 8; ++dt) { Sacc[dt] = Sacc[dt] * dc;
#pragma unroll
            for (int s2 = 0; s2 < 2; ++s2) Sacc[dt] = MFMA16(ldfrag8(bb + O_KT + (16 * dt + fr) * 136 + 64 * s2 + 8 * fq), Vd[s2], Sacc[dt]); }
        LAS float* Ot = (LAS float*)(lds + O_OT);
#pragma unroll
        for (int tm = 0; tm < 4; ++tm)
#pragma unroll
            for (int j = 0; j < 4; ++j) Ot[(16 * tm + 4 * fq + j) * 128 + 16 * wave + fr] = OO[tm][j];
        if (ch + 1 < SEQ / 64) SCAN_STORE(par ^ 1);
        __syncthreads();
        {
            float ov[16];
#pragma unroll
            for (int q4 = 0; q4 < 4; ++q4) { const f32x4 t = *(const LAS f32x4*)(Ot + ftk * 128 + fsub * 16 + q4 * 4); ov[4 * q4] = t.x; ov[4 * q4 + 1] = t.y; ov[4 * q4 + 2] = t.z; ov[4 * q4 + 3] = t.w; }
            v4u o0, o1; o0.x = cvtpk(ov[0], ov[1]); o0.y = cvtpk(ov[2], ov[3]); o0.z = cvtpk(ov[4], ov[5]); o0.w = cvtpk(ov[6], ov[7]); o1.x = cvtpk(ov[8], ov[9]); o1.y = cvtpk(ov[10], ov[11]); o1.z = cvtpk(ov[12], ov[13]); o1.w = cvtpk(ov[14], ov[15]);
            bf16* dst = OR + (size_t)(mb + ftk) * 512 + h * 128 + fsub * 16; *(v4u*)dst = o0; *(v4u*)(dst + 8) = o1;
        }
        __syncthreads();
    }
#undef SCAN_LOAD
#undef SCAN_STORE
}


__device__ __forceinline__ void gate_phase(CParams p, const Ctx cx, int l, int wave, int lane) {
    const bf16* OR = (const bf16*)(((unsigned char*)p->ws) + WS_ORAW); const bf16* Z = (const bf16*)(((unsigned char*)p->ws) + WS_Z); bf16* MX = (bf16*)((float*)p->out);
    const int gw = cx.bx * NWAVES + wave, NGW = gridDim.x * NWAVES, sub = lane & 15, rl = lane >> 4;
    float wn[8];
#pragma unroll
    for (int e = 0; e < 8; ++e) wn[e] = ((const float*)p->dn_out_norm)[l * 128 + 8 * sub + e];
    constexpr int RB = 4;
    for (int itb = gw; itb < M; itb += NGW * RB) {
        v4u oa[RB], za[RB];
#pragma unroll
        for (int q = 0; q < RB; ++q) { const size_t off = (size_t)(itb + q * NGW) * 512 + rl * 128 + 8 * sub; oa[q] = *(const v4u*)(OR + off); za[q] = *(const v4u*)(Z + off); }
#pragma unroll
        for (int q = 0; q < RB; ++q) {
            const float o[8] = {bflo(oa[q].x), bfhi(oa[q].x), bflo(oa[q].y), bfhi(oa[q].y), bflo(oa[q].z), bfhi(oa[q].z), bflo(oa[q].w), bfhi(oa[q].w)};
            const float z[8] = {bflo(za[q].x), bfhi(za[q].x), bflo(za[q].y), bfhi(za[q].y), bflo(za[q].z), bfhi(za[q].z), bflo(za[q].w), bfhi(za[q].w)};
            float ss = 0.f;
#pragma unroll
            for (int e = 0; e < 8; ++e) ss += o[e] * o[e];
            ss += DPP_F(ss, 0xB1); ss += DPP_F(ss, 0x4E); ss += DPP_F(ss, 0x141); ss += DPP_F(ss, 0x140);
            const float rstd = rsqrtf(ss * (1.f / 128.f) + EPS);
            float r[8];
#pragma unroll
            for (int e = 0; e < 8; ++e) r[e] = o[e] * rstd * wn[e] * silu_f(z[e]);
            v4u w; w.x = cvtpk(r[0], r[1]); w.y = cvtpk(r[2], r[3]); w.z = cvtpk(r[4], r[5]); w.w = cvtpk(r[6], r[7]);
            *(v4u*)(MX + (size_t)(itb + q * NGW) * 1024 + rl * 128 + 8 * sub) = w;
        }
    }
}

__device__ __forceinline__ float gelu_tanh_f(float x) { const float z = 0.7978845608028654f * (x + 0.044715f * x * x * x); return x * __builtin_amdgcn_rcpf(1.f + __expf(-2.f * z)); }
__device__ __forceinline__ void ffn_conv_phase(CParams p, const Ctx cx, int l, int hf) {
    const bf16* U = (const bf16*)(((unsigned char*)p->ws) + WS_U); bf16* ACT = (bf16*)(((unsigned char*)p->ws) + WS_ACT);
    const float* cw = ((const float*)p->ffn_conv) + (size_t)l * 3 * DFF2; const float* cb = ((const float*)p->ffn_conv_bias) + (size_t)l * DFF2;
    const int hw = hf ? 1280 : 1536, coff = hf ? 1536 : 0, ncg = hw / 8, ldu = 2 * hw;
    for (int it = cx.bx * NTHR + cx.tid; it < (M / 16) * ncg; it += gridDim.x * NTHR) {
        const int cgp = it % ncg, rr = it / ncg, m0 = rr * 16, c0 = cgp * 8, pos0 = m0 & (SEQ - 1), gc = coff + c0;
        float wg[3][8], wv[3][8], bg[8], bv[8], pg[2][8], pv[2][8];
#pragma unroll
        for (int j = 0; j < 3; ++j)
#pragma unroll
            for (int e = 0; e < 8; ++e) { wg[j][e] = cw[j * DFF2 + gc + e]; wv[j][e] = cw[j * DFF2 + DFF + gc + e]; }
#pragma unroll
        for (int e = 0; e < 8; ++e) { bg[e] = cb[gc + e]; bv[e] = cb[DFF + gc + e]; }
#pragma unroll
        for (int k = 0; k < 2; ++k) {
            v4u a = {0u, 0u, 0u, 0u}, b = {0u, 0u, 0u, 0u};
            if (pos0 > 0) { a = *(const v4u*)(U + (size_t)(m0 - 2 + k) * ldu + c0); b = *(const v4u*)(U + (size_t)(m0 - 2 + k) * ldu + hw + c0); }
            pg[k][0] = bflo(a.x); pg[k][1] = bfhi(a.x); pg[k][2] = bflo(a.y); pg[k][3] = bfhi(a.y); pg[k][4] = bflo(a.z); pg[k][5] = bfhi(a.z); pg[k][6] = bflo(a.w); pg[k][7] = bfhi(a.w);
            pv[k][0] = bflo(b.x); pv[k][1] = bfhi(b.x); pv[k][2] = bflo(b.y); pv[k][3] = bfhi(b.y); pv[k][4] = bflo(b.z); pv[k][5] = bfhi(b.z); pv[k][6] = bflo(b.w); pv[k][7] = bfhi(b.w);
        }
#pragma unroll 1
        for (int rb = 0; rb < 16; rb += 8) {
            v4u la[8], lb[8];
#pragma unroll
            for (int r = 0; r < 8; ++r) { const int m = m0 + rb + r; la[r] = *(const v4u*)(U + (size_t)m * ldu + c0); lb[r] = *(const v4u*)(U + (size_t)m * ldu + hw + c0); }
#pragma unroll
            for (int r = 0; r < 8; ++r) {
                const int m = m0 + rb + r; const v4u a = la[r], b = lb[r];
                const float cg_[8] = {bflo(a.x), bfhi(a.x), bflo(a.y), bfhi(a.y), bflo(a.z), bfhi(a.z), bflo(a.w), bfhi(a.w)};
                const float cv_[8] = {bflo(b.x), bfhi(b.x), bflo(b.y), bfhi(b.y), bflo(b.z), bfhi(b.z), bflo(b.w), bfhi(b.w)};
                float o[8];
#pragma unroll
                for (int e = 0; e < 8; ++e) {
                    const float gt = wg[0][e] * pg[0][e] + wg[1][e] * pg[1][e] + wg[2][e] * cg_[e] + bg[e];
                    const float vl = wv[0][e] * pv[0][e] + wv[1][e] * pv[1][e] + wv[2][e] * cv_[e] + bv[e];
                    o[e] = gelu_tanh_f(gt) * vl;
                    pg[0][e] = pg[1][e]; pg[1][e] = cg_[e]; pv[0][e] = pv[1][e]; pv[1][e] = cv_[e];
                }
                v4u w; w.x = pk2(o[0], o[1]); w.y = pk2(o[2], o[3]); w.z = pk2(o[4], o[5]); w.w = pk2(o[6], o[7]);
                *(v4u*)(ACT + (size_t)m * DFF + coff + c0) = w;
            }
        }
    }
}


__device__ __forceinline__ void ffn_fixup(CParams p, const Ctx cx, int l, int pm) {
    const bf16* HL = (const bf16*)(((unsigned char*)p->ws) + ((size_t)440 << 20)); bf16* ACT = (bf16*)(((unsigned char*)p->ws) + WS_ACT);
    const float* cw = ((const float*)p->ffn_conv) + (size_t)l * 3 * DFF2; const float* cb = ((const float*)p->ffn_conv_bias) + (size_t)l * DFF2;
    for (int it = cx.tid; it < 4 * 352; it += NTHR) {
        const int si = it / 352, cgp = it % 352, pn = cgp >> 4, c0 = (cgp & 15) * 8, strip = pm * 4 + si, gc = pn * 128 + c0, colp = pn * 256 + c0;
        const bool first = ((strip * 64) & (SEQ - 1)) == 0;
        float ug[4][8], uv[4][8];
#pragma unroll
        for (int rr = 0; rr < 4; ++rr) {
            v4u a = {0u, 0u, 0u, 0u}, b = {0u, 0u, 0u, 0u};
            if (rr >= 2) { a = *(const v4u*)(HL + ((size_t)strip * 4 + (rr - 2)) * 5632 + colp); b = *(const v4u*)(HL + ((size_t)strip * 4 + (rr - 2)) * 5632 + colp + 128); }
            else if (!first) { a = *(const v4u*)(HL + ((size_t)(strip - 1) * 4 + 2 + rr) * 5632 + colp); b = *(const v4u*)(HL + ((size_t)(strip - 1) * 4 + 2 + rr) * 5632 + colp + 128); }
            ug[rr][0] = bflo(a.x); ug[rr][1] = bfhi(a.x); ug[rr][2] = bflo(a.y); ug[rr][3] = bfhi(a.y); ug[rr][4] = bflo(a.z); ug[rr][5] = bfhi(a.z); ug[rr][6] = bflo(a.w); ug[rr][7] = bfhi(a.w);
            uv[rr][0] = bflo(b.x); uv[rr][1] = bfhi(b.x); uv[rr][2] = bflo(b.y); uv[rr][3] = bfhi(b.y); uv[rr][4] = bflo(b.z); uv[rr][5] = bfhi(b.z); uv[rr][6] = bflo(b.w); uv[rr][7] = bfhi(b.w);
        }
#pragma unroll
        for (int ro = 0; ro < 2; ++ro) {
            float o[8];
#pragma unroll
            for (int e = 0; e < 8; ++e) {
                const float g = cw[gc + e] * ug[ro][e] + cw[DFF2 + gc + e] * ug[ro + 1][e] + cw[2 * DFF2 + gc + e] * ug[ro + 2][e] + cb[gc + e];
                const float v = cw[DFF + gc + e] * uv[ro][e] + cw[DFF2 + DFF + gc + e] * uv[ro + 1][e] + cw[2 * DFF2 + DFF + gc + e] * uv[ro + 2][e] + cb[DFF + gc + e];
                o[e] = gelu_tanh_f(g) * v;
            }
            v4u w; w.x = pk2(o[0], o[1]); w.y = pk2(o[2], o[3]); w.z = pk2(o[4], o[5]); w.w = pk2(o[6], o[7]);
            *(v4u*)(ACT + (size_t)(strip * 64 + ro) * DFF + gc) = w;
        }
    }
}

#define XB_TMO      128
#define XB_XCNT(j)  (256  + 64 * (j))
#define XB_XSUB(j)  (1280 + 64 * (j))
#define XB_XGEN(j)  (2304 + 64 * (j))
#define XB_TOP      3328
#define XB_TOPGEN   3392
#define XCD_BAR_WORDS 3456
#define XB_SPIN_CAP (1u << 22)

__device__ __forceinline__ unsigned xb_ld(unsigned* p)              { return __hip_atomic_load(p, __ATOMIC_RELAXED, __HIP_MEMORY_SCOPE_AGENT); }
__device__ __forceinline__ unsigned xb_add(unsigned* p, unsigned v) { return __hip_atomic_fetch_add(p, v, __ATOMIC_RELAXED, __HIP_MEMORY_SCOPE_AGENT); }
__device__ __forceinline__ unsigned xb_xcc_id() { return (unsigned)__builtin_amdgcn_s_getreg((3 << 11) | 20) & 0xFu; }
#define XB_SPIN(cond, bar) do { unsigned _sp = 0; while (cond) { __builtin_amdgcn_s_sleep(1); \
    if ((++_sp & 255u) == 0u) { if (xb_ld(&(bar)[XB_TMO])) break; if (_sp > XB_SPIN_CAP) { atomicAdd(&(bar)[XB_TMO], 1u); break; } } } } while (0)

struct XcdBarrier {
    unsigned* bar; unsigned x;
    volatile LAS unsigned* st;
};

__device__ __forceinline__ XcdBarrier xcd_barrier_post(unsigned* bar, volatile LAS unsigned* st) {
    XcdBarrier b; b.bar = bar; b.x = xb_xcc_id(); b.st = st;
    if (threadIdx.x == 0) (void)xb_add(&bar[XB_XCNT(b.x)], 1u);
    return b;
}
__device__ __forceinline__ void xcd_barrier_complete(unsigned* bar, unsigned x, unsigned& nloc, unsigned& nx) {
    const unsigned G = gridDim.x * gridDim.y * gridDim.z;
    unsigned sum, cnt, mine, sp = 0u;
    for (;;) {
        sum = 0u; cnt = 0u; mine = 0u;
#pragma unroll
        for (unsigned j = 0; j < 16; ++j) { const unsigned c = xb_ld(&bar[XB_XCNT(j)]); sum += c; cnt += (c > 0u) ? 1u : 0u; mine = (j == x) ? c : mine; }
        if (sum == G) break;
        __builtin_amdgcn_s_sleep(1);
        if ((++sp & 255u) == 0u) { if (xb_ld(&bar[XB_TMO])) break; if (sp > XB_SPIN_CAP) { atomicAdd(&bar[XB_TMO], 1u); break; } }
    }
    nloc = mine > 0u ? mine : 1u; nx = cnt > 0u ? cnt : 1u;
}

__device__ __forceinline__ void xcd_barrier(const XcdBarrier& b) {
    asm volatile("s_waitcnt vmcnt(0)" ::: "memory");
    __syncthreads();
    if (threadIdx.x == 0) {
        unsigned* bar = b.bar;
        __builtin_amdgcn_s_waitcnt(0);
        unsigned nloc = b.st[0], nx = b.st[1];
        if (nloc == 0u) { xcd_barrier_complete(bar, b.x, nloc, nx); b.st[0] = nloc; b.st[1] = nx; }
        const unsigned old = xb_add(&bar[XB_XSUB(b.x)], 1u);
        const unsigned gen = old / nloc;
        if (old + 1u == (gen + 1u) * nloc) {
            __builtin_amdgcn_fence(__ATOMIC_RELEASE, "agent");
            asm volatile("s_waitcnt vmcnt(0)" ::: "memory");
            const unsigned og = xb_add(&bar[XB_TOP], 1u);
            const unsigned tg = og / nx;
            if (og + 1u == (tg + 1u) * nx) xb_add(&bar[XB_TOPGEN], 1u);
            else XB_SPIN(xb_ld(&bar[XB_TOPGEN]) == tg, bar);
            __builtin_amdgcn_fence(__ATOMIC_ACQUIRE, "agent");
            xb_add(&bar[XB_XGEN(b.x)], 1u);
            asm volatile("s_waitcnt vmcnt(0)" ::: "memory");
        } else {
            XB_SPIN(xb_ld(&bar[XB_XGEN(b.x)]) == gen, bar);
            __builtin_amdgcn_fence(__ATOMIC_ACQUIRE, "agent");
            asm volatile("s_waitcnt vmcnt(0)" ::: "memory");
        }
    }
    __syncthreads();
}

__global__ void __launch_bounds__(NTHR, 2) mk_fwd(Params pv) {
    extern __shared__ __attribute__((aligned(16))) unsigned char smem[];
    cg::grid_group grid = cg::this_grid();
    LAS unsigned char* lds = (LAS unsigned char*)smem;
    constexpr int NPH = 1 + DEPTH * 9;
    {
        CParams p = (CParams)__builtin_amdgcn_kernarg_segment_ptr();
        Ctx cx; cx.tid = threadIdx.x; cx.bx = blockIdx.x; asm volatile("" : "+v"(cx.tid)); asm volatile("" : "+s"(cx.bx));
        const int lane = cx.tid & 63, wave = __builtin_amdgcn_readfirstlane(cx.tid >> 6);
        convert_weights(p, cx, 0, 0, lds, wave, lane);
        rope_table(p, cx);
        rowwise_phase(p, cx, ((const float*)p->x), nullptr, nullptr, ((const float*)p->pre_mix_norm), 0, lds, wave, lane);
        if (cx.bx == 0) for (int i = cx.tid; i < XCD_BAR_WORDS; i += NTHR) ((unsigned*)(((unsigned char*)p->ws)))[i] = 0u;
        if (cx.tid == 0) { ((volatile LAS unsigned*)(lds + LDS_BYTES - 16))[0] = 0u; ((volatile LAS unsigned*)(lds + LDS_BYTES - 16))[1] = 0u; }
        grid.sync();
    }
    XcdBarrier xbar = xcd_barrier_post((unsigned*)(((unsigned char*)((CParams)__builtin_amdgcn_kernarg_segment_ptr())->ws)), (volatile LAS unsigned*)(lds + LDS_BYTES - 16));
#ifndef PROBE_MASK
#define PROBE_MASK 0
#endif
#define PROBE_PART 0
    for (int ph2 = 2; ph2 < 2 * NPH; ++ph2) {
        const int ph = ph2 >> 1;
        if ((ph2 & 1) && !((PROBE_MASK >> ((ph - 1) % 9)) & 1)) continue;
        CParams p = (CParams)__builtin_amdgcn_kernarg_segment_ptr();
        asm volatile("" : "+s"(p));
        unsigned char* ws = ((unsigned char*)p->ws);
        Ctx cx; cx.tid = threadIdx.x; cx.bx = blockIdx.x; asm volatile("" : "+v"(cx.tid)); asm volatile("" : "+s"(cx.bx));
        const int tid = cx.tid, lane = tid & 63, wave = __builtin_amdgcn_readfirstlane(tid >> 6);
        const int l = (ph - 1) / 9, kk = (ph - 1) % 9, k = kk == 0 ? 0 : (kk == 1 ? 100 : (kk == 2 ? 2 : (kk == 3 ? 101 : (kk == 4 ? 3 : (kk == 5 ? 4 : (kk == 6 ? 5 : (kk == 7 ? 9 : 10)))))));
        if (k == 0 || k == 3 || k == 5 || k == 9) {
            pg8::Gemm g; pg8::EpiAny E; E.ws = ws; E.k = k; E.cw = ((const float*)p->ffn_conv) + (size_t)l * 3 * DFF2; E.cb = ((const float*)p->ffn_conv_bias) + (size_t)l * DFF2; const size_t wo = (l & 1) ? WS_WODD : 0;
            if (k == 0) { g.A = (const bf16*)((float*)p->out); g.Bt = (const bf16*)(ws + WS_WIN + wo); g.N = NIN; g.K = D; }
            else if (k == 3) { g.A = (const bf16*)((float*)p->out); g.Bt = (const bf16*)(ws + WS_WOUT + wo); g.N = D; g.K = D; }
            else if (k == 9) { g.A = (const bf16*)(ws + WS_ACT); g.Bt = (const bf16*)(ws + WS_WDOWN + wo); g.N = D; g.K = DFF; }
            else { g.A = (const bf16*)((float*)p->out); g.Bt = (const bf16*)(ws + WS_WUP + wo); g.N = DFF2; g.K = D; }
            g.M = M;
            pg8::StaticOrder S; S.init(M, g.N, (int)gridDim.x, cx.bx);
            if (k == 9) {
                pg8::Unit uu; for (int i = 0; S.next(i, uu); ++i) ffn_fixup(p, cx, l, uu.pm);
                asm volatile("s_waitcnt vmcnt(0)" ::: "memory"); __syncthreads();
            }
            pg8::gemm_phase<pg8::EpiAny, pg8::StaticOrder, true, true>(lds, g, S, E, tid);
        } else if (k == 100) {
#ifndef NAIVE_SCAN
            d0_phase(p, cx, l, wave, lane);
            asm volatile("s_waitcnt vmcnt(0)" ::: "memory"); __syncthreads();
            { const int G = gridDim.x; v4u pf0, pf1, pf2, pf3, pf4, pf5; const int u0 = cx.bx;
              pf0 = *(const v4u*)D1_ROWPTR(u0, 0); pf1 = *(const v4u*)D1_ROWPTR(u0, 1); pf2 = *(const v4u*)D1_ROWPTR(u0, 2); pf3 = *(const v4u*)D1_ROWPTR(u0, 3); pf4 = *(const v4u*)D1_ROWPTR(u0, 4); pf5 = *(const v4u*)D1_ROWPTR(u0, 5);
              for (int un = u0; un < BATCH * 4 * 64; un += G) d1_unit(p, cx, un, un + G < BATCH * 4 * 64 ? un + G : -1, pf0, pf1, pf2, pf3, pf4, pf5, lds, wave, lane); }
#endif
        } else if (k == 101) {
            gate_phase(p, cx, l, wave, lane);
        } else if (k == 2) {
            const int bx = cx.bx, G = gridDim.x;
#ifdef NAIVE_SCAN
            if (bx < 32) scan_naive_unit(p, cx, l, bx, lds, wave, lane);
#else
            if (bx < 32 && !((ph2 & 1) && PROBE_PART == 2)) scan_chunked_unit(p, cx, l, bx, lds, wave, lane);
#endif
#ifdef NAIVE_ATTN
            else { for (int it = (bx - 32) * NTHR + tid; it < M * 8; it += (G - 32) * NTHR) attn_naive_item(p, it); }
#else
            if (bx >= 32 && !((ph2 & 1) && PROBE_PART == 1)) { for (int bu = bx - 32; bu < BATCH * 8 * 16; bu += G - 32) { attn_stage(p, cx, bu, lds); attn_mfma_unit(p, bu * 8 + wave, lane, lds); }
                __syncthreads();
                if (l + 1 < DEPTH && !(ph2 & 1)) convert_weights(p, cx, l + 1, 32, lds, wave, lane); }
#endif
        } else if (k == 4) {
            rowwise_phase(p, cx, nullptr, (const bf16*)(ws + WS_Y), ((const float*)p->post_mix_norm) + l * D, ((const float*)p->pre_ffn_norm) + l * D, -1, lds, wave, lane);
        } else {
            if (l + 1 < DEPTH) {
                rowwise_phase(p, cx, nullptr, (const bf16*)(ws + WS_Y2), ((const float*)p->post_ffn_norm) + l * D, ((const float*)p->pre_mix_norm) + (l + 1) * D, l + 1, lds, wave, lane); }
            else rowwise_phase(p, cx, nullptr, (const bf16*)(ws + WS_Y2), ((const float*)p->post_ffn_norm) + l * D, nullptr, -1, lds, wave, lane);
        }
        if (ph2 + 1 < 2 * NPH) xcd_barrier(xbar);
    }
}

extern "C" void kernel_launch(void* const* d_in, const int* in_sizes, int n_in, void* d_out, int out_size, void* d_ws, size_t ws_size, hipStream_t stream) {
    static int grid_blocks = 0;
    if (grid_blocks == 0) {
        if (n_in != 15 || in_sizes[0] != M * D || out_size != M * D || ws_size < WS_NEED) { fprintf(stderr, "kernel_launch: unexpected shapes / workspace (n_in %d, ws %zu)\n", n_in, ws_size); grid_blocks = -1; return; }
        int dev = 0, cus = 0, per_cu = 0;
        hipGetDevice(&dev); hipDeviceGetAttribute(&cus, hipDeviceAttributeMultiprocessorCount, dev);
        if (hipFuncSetAttribute((const void*)mk_fwd, hipFuncAttributeMaxDynamicSharedMemorySize, LDS_BYTES) != hipSuccess) { fprintf(stderr, "kernel_launch: hipFuncSetAttribute failed\n"); grid_blocks = -1; return; }
        if (hipOccupancyMaxActiveBlocksPerMultiprocessor(&per_cu, (const void*)mk_fwd, NTHR, LDS_BYTES) != hipSuccess || per_cu < 1) { fprintf(stderr, "kernel_launch: occupancy query gave %d\n", per_cu); per_cu = 1; }
        (void)hipGetLastError();
        grid_blocks = cus * 1;
    }
    if (grid_blocks < 0) return;
    Params p{};
    p.x = (GAS const float*)d_in[0]; p.pre_mix_norm = (GAS const float*)d_in[1]; p.w_in = (GAS const float*)d_in[2]; p.dn_conv = (GAS const float*)d_in[3]; p.dn_a_log = (GAS const float*)d_in[4];
    p.dn_dt_bias = (GAS const float*)d_in[5]; p.dn_out_norm = (GAS const float*)d_in[6]; p.w_out = (GAS const float*)d_in[7]; p.post_mix_norm = (GAS const float*)d_in[8]; p.pre_ffn_norm = (GAS const float*)d_in[9];
    p.ffn_up = (GAS const float*)d_in[10]; p.ffn_conv = (GAS const float*)d_in[11]; p.ffn_conv_bias = (GAS const float*)d_in[12]; p.ffn_down = (GAS const float*)d_in[13]; p.post_ffn_norm = (GAS const float*)d_in[14];
    p.out = (GAS float*)d_out; p.ws = (GAS unsigned char*)d_ws;
    void* args[] = {&p};
    hipError_t e = hipLaunchCooperativeKernel((const void*)mk_fwd, dim3(grid_blocks), dim3(NTHR), args, LDS_BYTES, stream);
    if (e != hipSuccess) fprintf(stderr, "kernel_launch: cooperative launch failed: %s (grid %d)\n", hipGetErrorString(e), grid_blocks);
}
```

```cpp
#include <hip/hip_runtime.h>
#include <hip/hip_cooperative_groups.h>
#include <cstdio>
#include <cstdint>
namespace cg = cooperative_groups;

namespace pg8 {
#define PG8_LAS __attribute__((address_space(3)))
typedef unsigned short bf16_t;
typedef short bf16x8 __attribute__((ext_vector_type(8)));
typedef float f32x4 __attribute__((ext_vector_type(4)));
typedef unsigned u32x4 __attribute__((ext_vector_type(4)));
constexpr int BM = 256, BK = 64, HALF = 128, HTB = HALF * BK * 2  , STAGE_BYTES = 8 * HTB, NXCD = 8, WGM = 8;

__host__ __device__ __forceinline__ int lds_byte(int r, int c) { const int st = (r >> 4) * 2 + (c >> 5), rr = r & 15, cc = c & 31, ob = rr * 64 + cc * 2; return st * 1024 + (ob ^ (((ob >> 9) & 1) << 5)); }
__host__ __device__ __forceinline__ void stage_rc(int b, int& R, int& C) { const int st = b / 1024, sb = b % 1024, swz = sb ^ (((sb >> 9) & 1) << 5); R = (st >> 1) * 16 + swz / 64; C = (st & 1) * 32 + (swz % 64) / 2; }
__host__ __device__ __forceinline__ int perm32(int rho) { const int n = rho >> 4, i = rho & 15; return 8 * (i >> 2) + 4 * n + (i & 3); }

struct Unit { int pm, pn; };
struct Gemm { const bf16_t* A; const bf16_t* Bt; int M, N, K; };

struct StaticOrder {
    int nM, nN, nwg, G, c;
    __host__ __device__ void init(int M, int N, int G_, int c_) { nM = M / BM; nN = N / BM; nwg = nM * nN; G = G_; c = c_; }
    __host__ __device__ bool next(int i, Unit& u) const {
        const long L = (long)i * G + c; if (L >= nwg) return false;
        int wgid = (int)L; { const int q = nwg / NXCD, r = nwg % NXCD, xcd = wgid % NXCD, off = wgid / NXCD; wgid = (xcd < r ? xcd * (q + 1) : r * (q + 1) + (xcd - r) * q) + off; }
        const int nig = WGM * nN, gid = wgid / nig, fm = gid * WGM, gsz = (nM - fm) < WGM ? (nM - fm) : WGM;
        u.pm = fm + ((wgid % nig) % gsz); u.pn = (wgid % nig) / gsz; return true;
    }
    __device__ __forceinline__ void a_ready(const Unit&) const {}
    __device__ __forceinline__ void done(const Unit&) const {}
};

__device__ __forceinline__ unsigned cvt_pk_bf16(float lo, float hi) { unsigned r; asm volatile("v_cvt_pk_bf16_f32 %0, %1, %2" : "=v"(r) : "v"(lo), "v"(hi)); return r; }

struct EpiBf16 {
    static constexpr bool PERM = true, AFTER_DRAIN = false;
    bf16_t* O0; int ld0; int c1; bf16_t* O1; int ld1; int c2; bf16_t* O2; int ld2;
    __device__ __forceinline__ void operator()(const f32x4 (&acc)[2][2][4][2], const Unit& u, int wr, int wc, int fr, int fq) const {
        const int row0 = u.pm * BM + wr * 64 + fr; int colt = u.pn * BM; bf16_t* base = O0; int ldc = ld0;
        if (colt >= c2) { base = O2; ldc = ld2; colt -= c2; } else if (colt >= c1) { base = O1; ldc = ld1; colt -= c1; }
        const int col0 = colt + wc * 32 + 8 * fq;
#pragma unroll
        for (int ai = 0; ai < 2; ++ai)
#pragma unroll
            for (int m = 0; m < 4; ++m) { bf16_t* rowp = base + (size_t)(row0 + ai * HALF + m * 16) * ldc + col0;
#pragma unroll
                for (int bj = 0; bj < 2; ++bj) { const f32x4 v0 = acc[ai][bj][m][0], v1 = acc[ai][bj][m][1];
                    u32x4 w; w.x = cvt_pk_bf16(v0[0], v0[1]); w.y = cvt_pk_bf16(v0[2], v0[3]); w.z = cvt_pk_bf16(v1[0], v1[1]); w.w = cvt_pk_bf16(v1[2], v1[3]);
                    *(u32x4*)(rowp + bj * HALF) = w; } }
    }
};
struct EpiAny {
    static constexpr bool PERM = true, AFTER_DRAIN = false;
    unsigned char* ws; int k; const float* cw; const float* cb;
    __device__ __forceinline__ void operator()(const f32x4 (&acc)[2][2][4][2], const Unit& u, int wr, int wc, int fr, int fq) const {
        const int row0 = u.pm * BM + wr * 64 + fr; int colt = u.pn * BM;
        if (k == 5) {
            bf16_t* act = (bf16_t*)(ws + ((size_t)96 << 20)); bf16_t* halo = (bf16_t*)(ws + ((size_t)440 << 20));
            const int ch0 = u.pn * 128 + wc * 32 + 8 * fq;
#define ROR1(x) __builtin_bit_cast(float, __builtin_amdgcn_update_dpp(0, __builtin_bit_cast(int, (x)), 0x121, 0xf, 0xf, false))
#define ROR2(x) __builtin_bit_cast(float, __builtin_amdgcn_update_dpp(0, __builtin_bit_cast(int, (x)), 0x122, 0xf, 0xf, false))
#pragma unroll
            for (int n = 0; n < 2; ++n) {
                float wg[3][4], wv[3][4], bg[4], bv[4];
#pragma unroll
                for (int e = 0; e < 4; ++e) { const int c = ch0 + 4 * n + e;
#pragma unroll
                    for (int j = 0; j < 3; ++j) { wg[j][e] = cw[j * 5632 + c]; wv[j][e] = cw[j * 5632 + 2816 + c]; }
                    bg[e] = cb[c]; bv[e] = cb[2816 + c]; }
#pragma unroll
                for (int ai = 0; ai < 2; ++ai) {
                    const int strip = u.pm * 4 + ai * 2 + wr;
#pragma unroll
                    for (int m = 0; m < 4; ++m) {
                        const f32x4 gq = acc[ai][0][m][n], vq = acc[ai][1][m][n]; float o[4];
                        const f32x4 gp = m ? acc[ai][0][m ? m - 1 : 0][n] : (f32x4){0.f, 0.f, 0.f, 0.f}, vp = m ? acc[ai][1][m ? m - 1 : 0][n] : (f32x4){0.f, 0.f, 0.f, 0.f};
#pragma unroll
                        for (int e = 0; e < 4; ++e) {
                            const float g = gq[e], v = vq[e];
                            const float sg1 = fr == 15 ? gp[e] : g, sg2 = fr >= 14 ? gp[e] : g, sv1 = fr == 15 ? vp[e] : v, sv2 = fr >= 14 ? vp[e] : v;
                            const float a1g = ROR1(sg1), a2g = ROR2(sg2), a1v = ROR1(sv1), a2v = ROR2(sv2);
                            const float gc = wg[0][e] * a2g + wg[1][e] * a1g + wg[2][e] * g + bg[e];
                            const float vc = wv[0][e] * a2v + wv[1][e] * a1v + wv[2][e] * v + bv[e];
                            const float z = 0.7978845608028654f * (gc + 0.044715f * gc * gc * gc);
                            o[e] = gc * __builtin_amdgcn_rcpf(1.f + __expf(-2.f * z)) * vc;
                        }
                        typedef unsigned u32x2 __attribute__((ext_vector_type(2)));
                        u32x2 w; w.x = cvt_pk_bf16(o[0], o[1]); w.y = cvt_pk_bf16(o[2], o[3]);
                        *(u32x2*)(act + (size_t)(row0 + ai * HALF + m * 16) * 2816 + ch0 + 4 * n) = w;
                        if ((m == 0 && fr < 2) || (m == 3 && fr >= 14)) {
                            const int slot = (m == 0) ? fr : fr - 12;
                            bf16_t* hp = halo + ((size_t)strip * 4 + slot) * 5632 + u.pn * 256 + wc * 32 + 8 * fq + 4 * n;
                            u32x2 hg, hv; hg.x = cvt_pk_bf16(gq[0], gq[1]); hg.y = cvt_pk_bf16(gq[2], gq[3]); hv.x = cvt_pk_bf16(vq[0], vq[1]); hv.y = cvt_pk_bf16(vq[2], vq[3]);
                            *(u32x2*)hp = hg; *(u32x2*)(hp + 128) = hv;
                        }
                    }
                }
            }
#undef ROR1
#undef ROR2
        } else {
            bf16_t* base; int ldc;
            if (k == 0) { if (colt >= 2048) { base = (bf16_t*)(ws + ((size_t)128 << 20)); ldc = 1536; colt -= 2048; } else if (colt >= 1536) { base = (bf16_t*)(ws + ((size_t)96 << 20)); ldc = 512; colt -= 1536; }
                          else { base = (bf16_t*)(ws + ((size_t)224 << 20)); ldc = 1536; } }
            else if (k == 3) { base = (bf16_t*)(ws + ((size_t)96 << 20)); ldc = 1024; }
            else if (k == 9) { base = (bf16_t*)(ws + ((size_t)272 << 20)); ldc = 1024; }
            else { base = (bf16_t*)(ws + ((size_t)272 << 20)); ldc = (k == 5) ? 3072 : 2560; }
            const int col0 = colt + wc * 32 + 8 * fq;
#pragma unroll
            for (int ai = 0; ai < 2; ++ai)
#pragma unroll
                for (int m = 0; m < 4; ++m) { bf16_t* rowp = base + (size_t)(row0 + ai * HALF + m * 16) * ldc + col0;
#pragma unroll
                    for (int bj = 0; bj < 2; ++bj) { const f32x4 v0 = acc[ai][bj][m][0], v1 = acc[ai][bj][m][1];
                        u32x4 w; w.x = cvt_pk_bf16(v0[0], v0[1]); w.y = cvt_pk_bf16(v0[2], v0[3]); w.z = cvt_pk_bf16(v1[0], v1[1]); w.w = cvt_pk_bf16(v1[2], v1[3]);
                        *(u32x4*)(rowp + bj * HALF) = w; } }
        }
    }
};
struct EpiF32 {
    static constexpr bool PERM = true, AFTER_DRAIN = false;
    float* O; int ldc;
    __device__ __forceinline__ void operator()(const f32x4 (&acc)[2][2][4][2], const Unit& u, int wr, int wc, int fr, int fq) const {
        const int row0 = u.pm * BM + wr * 64 + fr; const int col0 = u.pn * BM + wc * 32 + 8 * fq;
#pragma unroll
        for (int ai = 0; ai < 2; ++ai)
#pragma unroll
            for (int m = 0; m < 4; ++m) { float* rowp = O + (size_t)(row0 + ai * HALF + m * 16) * ldc + col0;
#pragma unroll
                for (int bj = 0; bj < 2; ++bj) { *(f32x4*)(rowp + bj * HALF) = acc[ai][bj][m][0]; *(f32x4*)(rowp + bj * HALF + 4) = acc[ai][bj][m][1]; } }
    }
};

template <class Epi, class Sched, bool ALIGN_EPI = false, bool SP2 = false>
__device__ __forceinline__ void gemm_phase(PG8_LAS unsigned char* lds, const Gemm g, const Sched& S, const Epi& E, const int tid) {
    const int wid = __builtin_amdgcn_readfirstlane(tid >> 6), lane = tid & 63, wr = wid >> 2, wc = wid & 3, fr = lane & 15, fq = lane >> 4;
    const int K = g.K, nt = K / BK;
    unsigned voffA[2], voffB[2];
#pragma unroll
    for (int i = 0; i < 2; ++i) { int R, C; stage_rc(tid * 16 + i * 8192, R, C); const int Rb = Epi::PERM ? ((R & ~31) + perm32(R & 31)) : R;
        voffA[i] = (unsigned)(R * K + C) * 2u; voffB[i] = (unsigned)(Rb * K + C) * 2u; }
    const size_t kstep = (size_t)(BK * 2);
    const size_t hstep = (size_t)HALF * K * 2;
    const size_t tstep = 2 * hstep;
    const unsigned ldsw = (unsigned)wid * 1024u;
    const int aoff = lds_byte(wr * 64 + fr, fq * 8), boff = lds_byte(wc * 32 + fr, fq * 8);
#define PG8_SA(b, h) (((b) * 2 + (h)) * HTB)
#define PG8_SB(b, h) ((4 + (b) * 2 + (h)) * HTB)
#define PG8_STAGE(bufoff, gbase, voff) do { _Pragma("unroll") for (int _i = 0; _i < 2; ++_i) \
        __builtin_amdgcn_global_load_lds((const unsigned*)((const char*)(gbase) + (voff)[_i]), (PG8_LAS unsigned*)(lds + (bufoff) + ldsw + _i * 8192), 16, 0, 0); } while (0)
#define PG8_LDA(dst, b, h) do { _Pragma("unroll") for (int m = 0; m < 4; ++m) _Pragma("unroll") for (int k = 0; k < 2; ++k) dst[m][k] = *(const PG8_LAS bf16x8*)(lds + PG8_SA(b, h) + aoff + m * 2048 + k * 1024); } while (0)
#define PG8_LDB(dst, b, h) do { _Pragma("unroll") for (int n = 0; n < 2; ++n) _Pragma("unroll") for (int k = 0; k < 2; ++k) dst[n][k] = *(const PG8_LAS bf16x8*)(lds + PG8_SB(b, h) + boff + n * 2048 + k * 1024); } while (0)
#define PG8_MMA(ai, bj, At, Bt) do { __builtin_amdgcn_s_setprio(1); _Pragma("unroll") for (int m = 0; m < 4; ++m) _Pragma("unroll") for (int n = 0; n < 2; ++n) _Pragma("unroll") for (int k = 0; k < 2; ++k) \
        acc[ai][bj][m][n] = __builtin_amdgcn_mfma_f32_16x16x32_bf16(Bt[n][k], At[m][k], acc[ai][bj][m][n], 0, 0, 0); __builtin_amdgcn_s_setprio(0); } while (0)
#define PG8_WAIT_V(n) asm volatile("s_waitcnt vmcnt(" #n ")" ::: "memory")
#define PG8_WAIT_L(n) asm volatile("s_waitcnt lgkmcnt(" #n ")" ::: "memory")
#define PG8_BAR __builtin_amdgcn_s_barrier()
#define PG8_SCHED __builtin_amdgcn_sched_barrier(0)
    Unit cur, nxt; int ui = 0;
    if (!S.next(0, cur)) return;
    f32x4 acc[2][2][4][2];
#pragma unroll
    for (int a = 0; a < 2; ++a)
#pragma unroll
        for (int b = 0; b < 2; ++b)
#pragma unroll
            for (int m = 0; m < 4; ++m)
#pragma unroll
                for (int n = 0; n < 2; ++n) acc[a][b][m][n] = (f32x4){0.f, 0.f, 0.f, 0.f};
    bf16x8 At[4][2], B0[2][2], B1[2][2];
    const char* cA = (const char*)g.A + (size_t)cur.pm * tstep; const char* cB = (const char*)g.Bt + (size_t)cur.pn * tstep;
    S.a_ready(cur);
    if constexpr (SP2) {
        PG8_STAGE(PG8_SB(0, 0), cB, voffB); PG8_STAGE(PG8_SB(0, 1), cB + hstep, voffB); PG8_STAGE(PG8_SA(0, 0), cA, voffA); PG8_STAGE(PG8_SA(0, 1), cA + hstep, voffA);
        if (wr == 1) PG8_BAR;
        PG8_WAIT_V(2); PG8_BAR;
        PG8_STAGE(PG8_SB(1, 0), cB + kstep, voffB); PG8_STAGE(PG8_SA(1, 0), cA + kstep, voffA); PG8_STAGE(PG8_SB(1, 1), cB + hstep + kstep, voffB);
        PG8_WAIT_V(6); PG8_BAR;
    } else {
        PG8_STAGE(PG8_SB(0, 0), cB, voffB); PG8_STAGE(PG8_SA(0, 0), cA, voffA); PG8_STAGE(PG8_SB(0, 1), cB + hstep, voffB); PG8_STAGE(PG8_SA(0, 1), cA + hstep, voffA);
        if (wr == 1) PG8_BAR;
        PG8_WAIT_V(4); PG8_BAR;
        PG8_STAGE(PG8_SB(1, 0), cB + kstep, voffB); PG8_STAGE(PG8_SA(1, 0), cA + kstep, voffA); PG8_STAGE(PG8_SB(1, 1), cB + hstep + kstep, voffB);
        PG8_WAIT_V(6); PG8_BAR;
    }
    for (;;) {
        const bool has_next = S.next(ui + 1, nxt);
        const char* nA = has_next ? (const char*)g.A + (size_t)nxt.pm * tstep : cA; const char* nB = has_next ? (const char*)g.Bt + (size_t)nxt.pn * tstep : cB;
        for (int t = 0; t < nt; t += 2) {
            const bool last = (t == nt - 2);
            const char* a1 = cA + (size_t)(t + 1) * kstep;
            const char* a2 = last ? nA : cA + (size_t)(t + 2) * kstep; const char* b2 = last ? nB : cB + (size_t)(t + 2) * kstep;
            const char* a3 = a2 + kstep; const char* b3 = b2 + kstep;
            if (last && has_next) S.a_ready(nxt);
            if constexpr (SP2) {
            PG8_LDB(B0, 0, 0); PG8_LDB(B1, 0, 1); PG8_SCHED; PG8_LDA(At, 0, 0); PG8_STAGE(PG8_SA(1, 1), a1 + hstep, voffA);
            PG8_WAIT_V(8); PG8_WAIT_L(0); PG8_BAR; PG8_MMA(0, 0, At, B0); PG8_MMA(0, 1, At, B1); PG8_BAR; PG8_SCHED;
            PG8_LDA(At, 0, 1); PG8_STAGE(PG8_SB(0, 0), b2, voffB); PG8_STAGE(PG8_SB(0, 1), b2 + hstep, voffB); PG8_STAGE(PG8_SA(0, 0), a2, voffA);
            PG8_WAIT_V(8); PG8_WAIT_L(0); PG8_BAR; PG8_MMA(1, 0, At, B0); PG8_MMA(1, 1, At, B1); PG8_BAR; PG8_SCHED;
            PG8_LDB(B0, 1, 0); PG8_LDB(B1, 1, 1); PG8_SCHED; PG8_LDA(At, 1, 0); PG8_STAGE(PG8_SA(0, 1), a2 + hstep, voffA);
            PG8_WAIT_V(8); PG8_WAIT_L(0); PG8_BAR; PG8_MMA(0, 0, At, B0); PG8_MMA(0, 1, At, B1); PG8_BAR; PG8_SCHED;
            PG8_LDA(At, 1, 1); PG8_STAGE(PG8_SB(1, 0), b3, voffB); PG8_STAGE(PG8_SB(1, 1), b3 + hstep, voffB); PG8_STAGE(PG8_SA(1, 0), a3, voffA);
            PG8_WAIT_V(8); PG8_WAIT_L(0); PG8_BAR; PG8_MMA(1, 0, At, B0); PG8_MMA(1, 1, At, B1); PG8_BAR; PG8_SCHED;
            } else {
            PG8_LDB(B0, 0, 0); PG8_SCHED; PG8_LDA(At, 0, 0); PG8_STAGE(PG8_SA(1, 1), a1 + hstep, voffA);
            PG8_WAIT_L(8); PG8_BAR; PG8_WAIT_L(0); PG8_MMA(0, 0, At, B0); PG8_BAR; PG8_SCHED;
            PG8_LDB(B1, 0, 1); PG8_STAGE(PG8_SB(0, 0), b2, voffB);
            PG8_BAR; PG8_WAIT_L(0); PG8_MMA(0, 1, At, B1); PG8_BAR;
            PG8_LDA(At, 0, 1); PG8_STAGE(PG8_SA(0, 0), a2, voffA);
            PG8_BAR; PG8_WAIT_L(0); PG8_MMA(1, 0, At, B0); PG8_BAR; PG8_SCHED;
            PG8_STAGE(PG8_SB(0, 1), b2 + hstep, voffB);
            PG8_WAIT_V(6); PG8_BAR; PG8_MMA(1, 1, At, B1); PG8_BAR;
            PG8_LDB(B0, 1, 0); PG8_SCHED; PG8_LDA(At, 1, 0); PG8_STAGE(PG8_SA(0, 1), a2 + hstep, voffA);
            PG8_WAIT_L(8); PG8_BAR; PG8_WAIT_L(0); PG8_MMA(0, 0, At, B0); PG8_BAR; PG8_SCHED;
            PG8_LDB(B1, 1, 1); PG8_STAGE(PG8_SB(1, 0), b3, voffB);
            PG8_BAR; PG8_WAIT_L(0); PG8_MMA(0, 1, At, B1); PG8_BAR;
            PG8_LDA(At, 1, 1); PG8_STAGE(PG8_SA(1, 0), a3, voffA);
            PG8_BAR; PG8_WAIT_L(0); PG8_MMA(1, 0, At, B0); PG8_BAR; PG8_SCHED;
            PG8_STAGE(PG8_SB(1, 1), b3 + hstep, voffB);
            PG8_WAIT_V(6); PG8_BAR; PG8_MMA(1, 1, At, B1); PG8_BAR;
            }
        }
        if constexpr (ALIGN_EPI) { if (wr == 0) PG8_BAR; }
        if constexpr (!Epi::AFTER_DRAIN) { E(acc, cur, wr, wc, fr, fq); S.done(cur); }
        if (!has_next) break;
#pragma unroll
        for (int a = 0; a < 2; ++a)
#pragma unroll
            for (int b = 0; b < 2; ++b)
#pragma unroll
                for (int m = 0; m < 4; ++m)
#pragma unroll
                    for (int n = 0; n < 2; ++n) acc[a][b][m][n] = (f32x4){0.f, 0.f, 0.f, 0.f};
        cur = nxt; cA = nA; cB = nB; ++ui;
        if constexpr (ALIGN_EPI) { if (wr == 1) PG8_BAR; }
    }
    PG8_WAIT_V(0);
    if constexpr (!ALIGN_EPI) { if (wr == 0) PG8_BAR; }
    PG8_BAR;
    if constexpr (Epi::AFTER_DRAIN) { E.fused(acc, cur, wr, wc, fr, fq, lds, wid, lane); S.done(cur); }
#undef PG8_SA
#undef PG8_SB
#undef PG8_STAGE
#undef PG8_LDA
#undef PG8_LDB
#undef PG8_MMA
#undef PG8_WAIT_V
#undef PG8_WAIT_L
#undef PG8_BAR
#undef PG8_SCHED
}
}

#define LAS __attribute__((address_space(3)))
typedef unsigned short bf16;
typedef unsigned v4u __attribute__((ext_vector_type(4)));
typedef unsigned v2u __attribute__((ext_vector_type(2)));
typedef float f32x4 __attribute__((ext_vector_type(4)));
typedef short bf16x8 __attribute__((ext_vector_type(8)));
constexpr int NTHR = 512, NWAVES = 8;
constexpr int BATCH = 8, SEQ = 4096, M = BATCH * SEQ, D = 1024, DEPTH = 4;
constexpr int IN_W = 3592, NIN = 3584, DFF = 2816, DFF2 = 5632, HALF_FF = 1408;
constexpr float EPS = 1e-6f;
constexpr size_t MiB = 1u << 20;
constexpr size_t WS_WIN = 1 * MiB, WS_WOUT = 8 * MiB, WS_WUP = 10 * MiB, WS_WDOWN = 21 * MiB;
constexpr size_t WS_ROPE = 27 * MiB, WS_GATES = 28 * MiB;
constexpr size_t WS_XB = 32 * MiB;
constexpr size_t WS_Z = 96 * MiB, WS_BQKV = 128 * MiB, WS_AQKV = 224 * MiB, WS_QKVN = 320 * MiB;
constexpr size_t WS_Y = 96 * MiB;
constexpr size_t WS_ACT = 96 * MiB, WS_U = 272 * MiB, WS_Y2 = 272 * MiB;
constexpr size_t WS_NEED = 506 * MiB;
constexpr size_t WS_WODD = 479 * MiB;
constexpr int LDS_BYTES = 163840;
static_assert(WS_Y == (96u << 20) && WS_Y2 == (272u << 20) && WS_BQKV == (128u << 20) && WS_Z == (96u << 20) && WS_AQKV == (224u << 20) && WS_U == (272u << 20), "EpiAny hard-codes these offsets");

#define GAS __attribute__((address_space(1)))
struct Params {
    GAS const float* x; GAS const float* pre_mix_norm; GAS const float* w_in; GAS const float* dn_conv; GAS const float* dn_a_log; GAS const float* dn_dt_bias; GAS const float* dn_out_norm;
    GAS const float* w_out; GAS const float* post_mix_norm; GAS const float* pre_ffn_norm; GAS const float* ffn_up; GAS const float* ffn_conv; GAS const float* ffn_conv_bias;
    GAS const float* ffn_down; GAS const float* post_ffn_norm; GAS float* out; GAS unsigned char* ws;
};

typedef __attribute__((address_space(4))) const Params* CParams;
struct Ctx { int tid, bx; };
__device__ __forceinline__ unsigned f2bf(float f) { unsigned u = __float_as_uint(f); return (u + 0x7fffu + ((u >> 16) & 1u)) >> 16; }
typedef __bf16 bf16x2_t __attribute__((ext_vector_type(2)));
typedef float f32x2_t __attribute__((ext_vector_type(2)));
__device__ __forceinline__ unsigned cvtpk(float lo, float hi) { f32x2_t v = {lo, hi}; bf16x2_t b = __builtin_convertvector(v, bf16x2_t); return __builtin_bit_cast(unsigned, b); }
__device__ __forceinline__ unsigned pk2(float lo, float hi) { return cvtpk(lo, hi); }
__device__ __forceinline__ float bflo(unsigned u) { return __uint_as_float(u << 16); }
__device__ __forceinline__ float bfhi(unsigned u) { return __uint_as_float(u & 0xffff0000u); }
__device__ __forceinline__ float dpp_add(float v, const int ctrl_dummy) { return v; }
#define DPP_F(v, ctrl) __builtin_bit_cast(float, __builtin_amdgcn_update_dpp(0, __builtin_bit_cast(int, (v)), (ctrl), 0xf, 0xf, true))
__device__ __forceinline__ float wave_sum(float v) {
    v += DPP_F(v, 0xB1); v += DPP_F(v, 0x4E); v += DPP_F(v, 0x141); v += DPP_F(v, 0x140);
    const float r0 = __builtin_bit_cast(float, __builtin_amdgcn_readlane(__builtin_bit_cast(int, v), 0)), r1 = __builtin_bit_cast(float, __builtin_amdgcn_readlane(__builtin_bit_cast(int, v), 16));
    const float r2 = __builtin_bit_cast(float, __builtin_amdgcn_readlane(__builtin_bit_cast(int, v), 32)), r3 = __builtin_bit_cast(float, __builtin_amdgcn_readlane(__builtin_bit_cast(int, v), 48));
    return (r0 + r1) + (r2 + r3);
}
__device__ __forceinline__ float shflx(float v, int o, int lane) { return __builtin_bit_cast(float, __builtin_amdgcn_ds_bpermute((lane ^ o) << 2, __builtin_bit_cast(int, v))); }
__device__ __forceinline__ float silu_f(float y) { return y * __builtin_amdgcn_rcpf(1.f + __expf(-y)); }

__device__ __forceinline__ void transpose_item(const float* W, int ldw, int src_col0, int k0, bf16* WT, int K, int dst_row0, LAS float* scr, int lane) {
#pragma unroll 8
    for (int i = 0; i < 32; ++i) { const int kk = 2 * i + (lane >> 5); scr[kk * 33 + (lane & 31)] = W[(size_t)(k0 + kk) * ldw + src_col0 + (lane & 31)]; }
    asm volatile("s_waitcnt lgkmcnt(0)" ::: "memory");
    const int c = lane & 7;
#pragma unroll
    for (int j = 0; j < 4; ++j) { const int n = (lane >> 3) + 8 * j; const LAS float* s = scr + (8 * c) * 33 + n;
        v4u o; o.x = pk2(s[0 * 33], s[1 * 33]); o.y = pk2(s[2 * 33], s[3 * 33]); o.z = pk2(s[4 * 33], s[5 * 33]); o.w = pk2(s[6 * 33], s[7 * 33]);
        *(v4u*)(WT + (size_t)(dst_row0 + n) * K + k0 + 8 * c) = o; }
    asm volatile("s_waitcnt lgkmcnt(0)" ::: "memory");
}
__device__ __forceinline__ void convert_weights(CParams p, const Ctx cx, int l, int b0, LAS unsigned char* lds, int wave, int lane) {
    LAS float* scr = (LAS float*)(lds + 65536 + wave * 8448);
    const int gw = (cx.bx - b0) * NWAVES + wave, NGW = ((int)gridDim.x - b0) * NWAVES; const size_t wo = (l & 1) ? WS_WODD : 0;
    constexpr int I_IN = 16 * 112, I_OUT = 16 * 32, I_UP = 16 * 176, I_DN = 44 * 32;
    bf16* WinT = (bf16*)(((unsigned char*)p->ws) + WS_WIN + wo); bf16* WoutT = (bf16*)(((unsigned char*)p->ws) + WS_WOUT + wo); bf16* WupT = (bf16*)(((unsigned char*)p->ws) + WS_WUP + wo); bf16* WdnT = (bf16*)(((unsigned char*)p->ws) + WS_WDOWN + wo);
    for (int it = gw; it < I_IN + I_OUT + I_UP + I_DN; it += NGW) {
        int r = it;
        if (r < I_IN) { const int kb = r / 112, nb = r % 112, d0 = nb * 32, s0 = d0 < 2048 ? d0 : d0 + 8;
            transpose_item(((const float*)p->w_in) + (size_t)l * D * IN_W, IN_W, s0, kb * 64, WinT, D, d0, scr, lane); continue; } r -= I_IN;
        if (r < I_OUT) { const int kb = r / 32, nb = r % 32;
            transpose_item(((const float*)p->w_out) + (size_t)l * D * D, D, nb * 32, kb * 64, WoutT, D, nb * 32, scr, lane); continue; } r -= I_OUT;
        if (r < I_UP) { const int kb = r / 176, nb = r % 176, d0 = nb * 32, s0 = ((d0 & 255) >> 7) * DFF + (d0 >> 8) * 128 + (d0 & 127);
            transpose_item(((const float*)p->ffn_up) + (size_t)l * D * DFF2, DFF2, s0, kb * 64, WupT, D, d0, scr, lane); continue; } r -= I_UP;
        { const int kb = r / 32, nb = r % 32;
            transpose_item(((const float*)p->ffn_down) + (size_t)l * DFF * D, D, nb * 32, kb * 64, WdnT, DFF, nb * 32, scr, lane); }
    }
}
__device__ __forceinline__ void rope_table(CParams p, const Ctx cx) {
    float* tab = (float*)(((unsigned char*)p->ws) + WS_ROPE);
    const float invf[8] = {1.0f, 0.1939227432012558f, 0.03760603070259094f, 0.007292664609849453f, 0.0014142135623842478f, 0.00027424818836152554f, 5.3182957344688475e-05f, 1.0313385246263351e-05f};
    for (int i = cx.bx * NTHR + cx.tid; i < SEQ * 8; i += gridDim.x * NTHR) {
        const int pos = i >> 3, f = i & 7;
        float fr = invf[0];
#pragma unroll
        for (int q = 1; q < 8; ++q) fr = (f == q) ? invf[q] : fr;
        const float ang = (float)pos * fr;
        const double ad = (double)ang; const double n = __builtin_rint(ad * 0.15915494309189535); const float r = (float)(ad - n * 6.283185307179586);
        tab[pos * 16 + f] = cosf(r); tab[pos * 16 + 8 + f] = sinf(r);
    }
}

__device__ __forceinline__ void rowwise_phase(CParams p, const Ctx cx, const float* xsrc, const bf16* y, const float* wpost, const float* wpre, int gates_l, LAS unsigned char* lds, int wave, int lane) {
    LAS f32x4* gt = (LAS f32x4*)lds;
    if (gates_l >= 0) {
        const float* Wg = ((const float*)p->w_in) + (size_t)gates_l * D * IN_W + 2048;
        for (int i = cx.tid; i < 2048; i += NTHR) { const int ln = i & 63, half = (i >> 6) & 1, je = i >> 7, j = je >> 2, e = je & 3; const int k = 4 * ln + 256 * j + e;
            const float* s = Wg + (size_t)k * IN_W + 4 * half; gt[i] = (f32x4){s[0], s[1], s[2], s[3]}; }
        __syncthreads();
    }
    float* outp = ((float*)p->out); bf16* H = (bf16*)((float*)p->out); bf16* XB = (bf16*)(((unsigned char*)p->ws) + WS_XB); float* G = (float*)(((unsigned char*)p->ws) + WS_GATES);
    const int gw = cx.bx * NWAVES + wave, NGW = gridDim.x * NWAVES;
    f32x4 wpo[4], wpr[4];
#pragma unroll
    for (int j = 0; j < 4; ++j) { wpo[j] = wpost ? ((const f32x4*)wpost)[lane + 64 * j] : (f32x4){0.f, 0.f, 0.f, 0.f}; wpr[j] = wpre ? ((const f32x4*)wpre)[lane + 64 * j] : (f32x4){0.f, 0.f, 0.f, 0.f}; }
    constexpr int RB = 4;
    for (int rowb = gw; rowb < M; rowb += NGW * RB) {
        f32x4 xa[RB][4]; v2u ya[RB][4];
#pragma unroll
        for (int q = 0; q < RB; ++q) { const int row = rowb + q * NGW;
#pragma unroll
            for (int j = 0; j < 4; ++j) { if (xsrc) xa[q][j] = ((const f32x4*)(xsrc + (size_t)row * D))[lane + 64 * j]; else { const v2u xr = ((const v2u*)(XB + (size_t)row * D))[lane + 64 * j]; xa[q][j] = (f32x4){bflo(xr.x), bfhi(xr.x), bflo(xr.y), bfhi(xr.y)}; }
                if (y) ya[q][j] = ((const v2u*)(y + (size_t)row * D))[lane + 64 * j]; } }
#pragma unroll
        for (int q = 0; q < RB; ++q) {
        const int row = rowb + q * NGW;
        f32x4 xv[4];
#pragma unroll
        for (int j = 0; j < 4; ++j) xv[j] = xa[q][j];
        if (y) {
            f32x4 yv[4]; float s = 0.f;
#pragma unroll
            for (int j = 0; j < 4; ++j) { const v2u yr = ya[q][j]; yv[j] = (f32x4){bflo(yr.x), bfhi(yr.x), bflo(yr.y), bfhi(yr.y)}; s += (yv[j].x * yv[j].x + yv[j].y * yv[j].y) + (yv[j].z * yv[j].z + yv[j].w * yv[j].w); }
            const float ry = rsqrtf(wave_sum(s) * (1.f / D) + EPS);
#pragma unroll
            for (int j = 0; j < 4; ++j) xv[j] = xv[j] + yv[j] * ry * wpo[j];
        }
        if (wpre) {
#pragma unroll
            for (int j = 0; j < 4; ++j) { v2u o; o.x = pk2(xv[j].x, xv[j].y); o.y = pk2(xv[j].z, xv[j].w); ((v2u*)(XB + (size_t)row * D))[lane + 64 * j] = o; }
        } else {
#pragma unroll
            for (int j = 0; j < 4; ++j) ((f32x4*)(outp + (size_t)row * D))[lane + 64 * j] = xv[j];
        }
        if (wpre) {
            float s = 0.f;
#pragma unroll
            for (int j = 0; j < 4; ++j) s += (xv[j].x * xv[j].x + xv[j].y * xv[j].y) + (xv[j].z * xv[j].z + xv[j].w * xv[j].w);
            const float rx = rsqrtf(wave_sum(s) * (1.f / D) + EPS);
            f32x4 hv[4];
#pragma unroll
            for (int j = 0; j < 4; ++j) { hv[j] = xv[j] * rx * wpr[j];
                v2u o; o.x = pk2(hv[j].x, hv[j].y); o.y = pk2(hv[j].z, hv[j].w); ((v2u*)(H + (size_t)row * D))[lane + 64 * j] = o; }
            if (gates_l >= 0) {
                f32x4 a0 = {0.f, 0.f, 0.f, 0.f}, a1 = {0.f, 0.f, 0.f, 0.f};
#pragma unroll
                for (int j = 0; j < 4; ++j)
#pragma unroll
                    for (int e = 0; e < 4; ++e) { const float hh = hv[j][e]; const f32x4 w0 = gt[((j * 4 + e) * 2 + 0) * 64 + lane], w1 = gt[((j * 4 + e) * 2 + 1) * 64 + lane]; a0 = a0 + w0 * hh; a1 = a1 + w1 * hh; }
                float s0 = wave_sum(a0.x), s1 = wave_sum(a0.y), s2 = wave_sum(a0.z), s3 = wave_sum(a0.w), s4 = wave_sum(a1.x), s5 = wave_sum(a1.y), s6 = wave_sum(a1.z), s7 = wave_sum(a1.w);
                if (lane < 8) {
                    float v = s0; v = lane == 1 ? s1 : v; v = lane == 2 ? s2 : v; v = lane == 3 ? s3 : v; v = lane == 4 ? s4 : v; v = lane == 5 ? s5 : v; v = lane == 6 ? s6 : v; v = lane == 7 ? s7 : v;
                    float r;
                    if (lane < 4) r = 1.f / (1.f + __expf(-v));
                    else { const int hd = lane - 4; const float t = v + ((const float*)p->dn_dt_bias)[gates_l * 4 + hd]; const float sp = t > 15.f ? t : __logf(1.f + __expf(t)); r = -__expf(((const float*)p->dn_a_log)[gates_l * 4 + hd]) * sp; }
                    G[(size_t)row * 8 + lane] = r;
                }
            }
        }
        }
    }
}

__device__ __forceinline__ void d0_phase(CParams p, const Ctx cx, int l, int wave, int lane) {
    const bf16* A = (const bf16*)(((unsigned char*)p->ws) + WS_AQKV); bf16* Q = (bf16*)(((unsigned char*)p->ws) + WS_QKVN);
    const float* cw = ((const float*)p->dn_conv) + (size_t)l * 4 * 1536;
    const int gw = cx.bx * NWAVES + wave, NGW = gridDim.x * NWAVES;
    (void)gw; (void)NGW;
    for (int j = wave; j < 4 * ((BATCH * 4 * 64 - cx.bx + (int)gridDim.x - 1) / (int)gridDim.x); j += NWAVES) {
        const int un = cx.bx + (int)gridDim.x * (j >> 2), bh = un >> 6, h = bh & 3, m0 = (bh >> 2) * SEQ + (un & 63) * 64 + 16 * (j & 3), pos0 = m0 & (SEQ - 1);
        float w[3][4][2], win[3][3][2];
#pragma unroll
        for (int mt = 0; mt < 3; ++mt) { const int col = mt * 512 + h * 128 + 2 * lane;
#pragma unroll
            for (int j = 0; j < 4; ++j) { w[mt][j][0] = cw[j * 1536 + col]; w[mt][j][1] = cw[j * 1536 + col + 1]; }
#pragma unroll
            for (int k = 0; k < 3; ++k) {
                unsigned u = 0u; if (pos0 - 3 + k >= 0) u = *(const unsigned*)(A + (size_t)(m0 - 3 + k) * 1536 + col);
                win[mt][k][0] = bflo(u); win[mt][k][1] = bfhi(u); } }
        unsigned lu[16][3];
#pragma unroll
        for (int r = 0; r < 16; ++r)
#pragma unroll
            for (int mt = 0; mt < 3; ++mt) lu[r][mt] = *(const unsigned*)(A + (size_t)(m0 + r) * 1536 + mt * 512 + h * 128 + 2 * lane);
#pragma unroll
        for (int r = 0; r < 16; ++r) {
            const int m = m0 + r; float yv[3][2];
#pragma unroll
            for (int mt = 0; mt < 3; ++mt) { const unsigned u = lu[r][mt];
                const float c0 = bflo(u), c1 = bfhi(u);
                const float y0 = w[mt][0][0] * win[mt][0][0] + w[mt][1][0] * win[mt][1][0] + w[mt][2][0] * win[mt][2][0] + w[mt][3][0] * c0;
                const float y1 = w[mt][0][1] * win[mt][0][1] + w[mt][1][1] * win[mt][1][1] + w[mt][2][1] * win[mt][2][1] + w[mt][3][1] * c1;
                win[mt][0][0] = win[mt][1][0]; win[mt][0][1] = win[mt][1][1]; win[mt][1][0] = win[mt][2][0]; win[mt][1][1] = win[mt][2][1]; win[mt][2][0] = c0; win[mt][2][1] = c1;
                yv[mt][0] = silu_f(y0); yv[mt][1] = silu_f(y1); }
            const float sq = wave_sum(yv[0][0] * yv[0][0] + yv[0][1] * yv[0][1]), sk = wave_sum(yv[1][0] * yv[1][0] + yv[1][1] * yv[1][1]);
            const float rq = rsqrtf(sq + EPS) * 0.08838834764831845f, rk = rsqrtf(sk + EPS);
            bf16* o = Q + (size_t)m * 1536 + h * 128 + 2 * lane;
            *(unsigned*)(o) = pk2(yv[0][0] * rq, yv[0][1] * rq); *(unsigned*)(o + 512) = pk2(yv[1][0] * rk, yv[1][1] * rk); *(unsigned*)(o + 1024) = pk2(yv[2][0], yv[2][1]);
        }
    }
    bf16* Bq = (bf16*)(((unsigned char*)p->ws) + WS_BQKV); const float* tab = (const float*)(((unsigned char*)p->ws) + WS_ROPE);
    for (int i = cx.bx * NTHR + cx.tid; i < M * 16; i += gridDim.x * NTHR) {
        const int m = i >> 4, hh = i & 15, pos = m & (SEQ - 1);
        bf16* ptr = Bq + (size_t)m * 1536 + hh * 64;
        const v4u a = *(const v4u*)ptr, b = *(const v4u*)(ptr + 8);
        const f32x4 c0 = *(const f32x4*)(tab + pos * 16), c1 = *(const f32x4*)(tab + pos * 16 + 4), s0 = *(const f32x4*)(tab + pos * 16 + 8), s1 = *(const f32x4*)(tab + pos * 16 + 12);
        const float x1[8] = {bflo(a.x), bfhi(a.x), bflo(a.y), bfhi(a.y), bflo(a.z), bfhi(a.z), bflo(a.w), bfhi(a.w)};
        const float x2[8] = {bflo(b.x), bfhi(b.x), bflo(b.y), bfhi(b.y), bflo(b.z), bfhi(b.z), bflo(b.w), bfhi(b.w)};
        const float cc[8] = {c0.x, c0.y, c0.z, c0.w, c1.x, c1.y, c1.z, c1.w}, ss[8] = {s0.x, s0.y, s0.z, s0.w, s1.x, s1.y, s1.z, s1.w};
        float o1[8], o2[8];
#pragma unroll
        for (int q = 0; q < 8; ++q) { o1[q] = x1[q] * cc[q] - x2[q] * ss[q]; o2[q] = x2[q] * cc[q] + x1[q] * ss[q]; }
        v4u oa, ob; oa.x = pk2(o1[0], o1[1]); oa.y = pk2(o1[2], o1[3]); oa.z = pk2(o1[4], o1[5]); oa.w = pk2(o1[6], o1[7]);
        ob.x = pk2(o2[0], o2[1]); ob.y = pk2(o2[2], o2[3]); ob.z = pk2(o2[4], o2[5]); ob.w = pk2(o2[6], o2[7]);
        *(v4u*)ptr = oa; *(v4u*)(ptr + 8) = ob;
    }
}

__device__ __forceinline__ void scan_naive_unit(CParams p, const Ctx cx, int l, int bh, LAS unsigned char* lds, int wave, int lane) {
    const int b = bh >> 2, h = bh & 3, tid = cx.tid;
    const bf16* Q = (const bf16*)(((unsigned char*)p->ws) + WS_QKVN); const float* G = (const float*)(((unsigned char*)p->ws) + WS_GATES); const bf16* Z = (const bf16*)(((unsigned char*)p->ws) + WS_Z); bf16* MX = (bf16*)((float*)p->out);
    LAS float* obuf = (LAS float*)(lds + 49152); LAS float* gbeta = (LAS float*)(lds + 81920); LAS float* galpha = gbeta + 64;
    const int c16 = lane & 15, part = lane >> 4, c = 16 * wave + c16;
    float S[32];
#pragma unroll
    for (int i = 0; i < 32; ++i) S[i] = 0.f;
    for (int ch = 0; ch < SEQ / 64; ++ch) {
        const int mbase = b * SEQ + ch * 64;
        __syncthreads();
#pragma unroll
        for (int r = 0; r < 6; ++r) { const int idx = tid + NTHR * r, mat = idx >> 10, rem = idx & 1023, tk = rem >> 4, seg = rem & 15;
            const v4u v = *(const v4u*)(Q + (size_t)(mbase + tk) * 1536 + mat * 512 + h * 128 + seg * 8);
            *(LAS v4u*)(lds + mat * 16384 + tk * 256 + seg * 16) = v; }
        if (tid < 64) { gbeta[tid] = G[(size_t)(mbase + tid) * 8 + h]; galpha[tid] = __expf(G[(size_t)(mbase + tid) * 8 + 4 + h]); }
        __syncthreads();
        for (int tk = 0; tk < 64; ++tk) {
            const float beta = gbeta[tk], alpha = galpha[tk];
            float kf[32], acc = 0.f;
#pragma unroll
            for (int q4 = 0; q4 < 4; ++q4) { const v4u kv = *(const LAS v4u*)(lds + 16384 + tk * 256 + part * 64 + q4 * 16);
                kf[8 * q4 + 0] = bflo(kv.x); kf[8 * q4 + 1] = bfhi(kv.x); kf[8 * q4 + 2] = bflo(kv.y); kf[8 * q4 + 3] = bfhi(kv.y);
                kf[8 * q4 + 4] = bflo(kv.z); kf[8 * q4 + 5] = bfhi(kv.z); kf[8 * q4 + 6] = bflo(kv.w); kf[8 * q4 + 7] = bfhi(kv.w); }
#pragma unroll
            for (int i = 0; i < 32; ++i) acc += kf[i] * S[i];
            acc += shflx(acc, 16, lane); acc += shflx(acc, 32, lane);
            const unsigned short vb = *(const LAS unsigned short*)(lds + 32768 + tk * 256 + c * 2);
            const float vn = beta * (__uint_as_float((unsigned)vb << 16) - alpha * acc);
            float o = 0.f;
#pragma unroll
            for (int q4 = 0; q4 < 4; ++q4) { const v4u qv = *(const LAS v4u*)(lds + tk * 256 + part * 64 + q4 * 16);
                const float qf[8] = {bflo(qv.x), bfhi(qv.x), bflo(qv.y), bfhi(qv.y), bflo(qv.z), bfhi(qv.z), bflo(qv.w), bfhi(qv.w)};
#pragma unroll
                for (int e = 0; e < 8; ++e) { const int i = 8 * q4 + e; S[i] = alpha * S[i] + kf[i] * vn; o += qf[e] * S[i]; } }
            o += shflx(o, 16, lane); o += shflx(o, 32, lane);
            if (part == 0) obuf[tk * 128 + c] = o;
        }
        __syncthreads();
        {
            const int tk = tid >> 3, sub = tid & 7, m = mbase + tk;
            float ov[16], ss = 0.f;
#pragma unroll
            for (int q4 = 0; q4 < 4; ++q4) { const f32x4 t = *(const LAS f32x4*)(obuf + tk * 128 + sub * 16 + q4 * 4); ov[4 * q4] = t.x; ov[4 * q4 + 1] = t.y; ov[4 * q4 + 2] = t.z; ov[4 * q4 + 3] = t.w; }
#pragma unroll
            for (int e = 0; e < 16; ++e) ss += ov[e] * ov[e];
            ss += DPP_F(ss, 0xB1); ss += DPP_F(ss, 0x4E); ss += DPP_F(ss, 0x141);
            const float rstd = rsqrtf(ss * (1.f / 128.f) + EPS);
            const v4u z0 = *(const v4u*)(Z + (size_t)m * 512 + h * 128 + sub * 16), z1 = *(const v4u*)(Z + (size_t)m * 512 + h * 128 + sub * 16 + 8);
            const float zf[16] = {bflo(z0.x), bfhi(z0.x), bflo(z0.y), bfhi(z0.y), bflo(z0.z), bfhi(z0.z), bflo(z0.w), bfhi(z0.w), bflo(z1.x), bfhi(z1.x), bflo(z1.y), bfhi(z1.y), bflo(z1.z), bfhi(z1.z), bflo(z1.w), bfhi(z1.w)};
            const float* wn = ((const float*)p->dn_out_norm) + l * 128 + sub * 16;
            float r[16];
#pragma unroll
            for (int e = 0; e < 16; ++e) r[e] = ov[e] * rstd * wn[e] * silu_f(zf[e]);
            v4u o0, o1; o0.x = pk2(r[0], r[1]); o0.y = pk2(r[2], r[3]); o0.z = pk2(r[4], r[5]); o0.w = pk2(r[6], r[7]); o1.x = pk2(r[8], r[9]); o1.y = pk2(r[10], r[11]); o1.z = pk2(r[12], r[13]); o1.w = pk2(r[14], r[15]);
            bf16* dst = MX + (size_t)m * 1024 + h * 128 + sub * 16; *(v4u*)dst = o0; *(v4u*)(dst + 8) = o1;
        }
    }
}

__device__ __forceinline__ void attn_naive_item(CParams p, int item) {
    const int m = item >> 3, hd = item & 7, pos = m & (SEQ - 1);
    const bf16* Bq = (const bf16*)(((unsigned char*)p->ws) + WS_BQKV); bf16* MX = (bf16*)((float*)p->out);
    float q[64], acc[64];
    { const bf16* qp = Bq + (size_t)m * 1536 + hd * 64;
#pragma unroll
      for (int s = 0; s < 8; ++s) { const v4u v = *(const v4u*)(qp + 8 * s); q[8 * s] = bflo(v.x); q[8 * s + 1] = bfhi(v.x); q[8 * s + 2] = bflo(v.y); q[8 * s + 3] = bfhi(v.y); q[8 * s + 4] = bflo(v.z); q[8 * s + 5] = bfhi(v.z); q[8 * s + 6] = bflo(v.w); q[8 * s + 7] = bfhi(v.w); } }
#pragma unroll
    for (int i = 0; i < 64; ++i) acc[i] = 0.f;
    float mx = -1e30f, lsum = 0.f;
    for (int g = 0; g < 3; ++g) {
        const int d = g == 0 ? 1 : (g == 1 ? 4 : 16);
        for (int j = 0; j <= 128; ++j) {
            if (pos - j * d < 0) break;
            const bf16* kp = Bq + (size_t)(m - j * d) * 1536 + 512 + hd * 64; const bf16* vp = kp + 512;
            float s = 0.f;
#pragma unroll
            for (int t = 0; t < 8; ++t) { const v4u v = *(const v4u*)(kp + 8 * t);
                s += q[8 * t] * bflo(v.x) + q[8 * t + 1] * bfhi(v.x) + q[8 * t + 2] * bflo(v.y) + q[8 * t + 3] * bfhi(v.y) + q[8 * t + 4] * bflo(v.z) + q[8 * t + 5] * bfhi(v.z) + q[8 * t + 6] * bflo(v.w) + q[8 * t + 7] * bfhi(v.w); }
            s *= 0.125f;
            const float mn = fmaxf(mx, s), sc = __expf(mx - mn), pe = __expf(s - mn);
            lsum = lsum * sc + pe; mx = mn;
#pragma unroll
            for (int t = 0; t < 8; ++t) { const v4u v = *(const v4u*)(vp + 8 * t);
                acc[8 * t] = acc[8 * t] * sc + pe * bflo(v.x); acc[8 * t + 1] = acc[8 * t + 1] * sc + pe * bfhi(v.x); acc[8 * t + 2] = acc[8 * t + 2] * sc + pe * bflo(v.y); acc[8 * t + 3] = acc[8 * t + 3] * sc + pe * bfhi(v.y);
                acc[8 * t + 4] = acc[8 * t + 4] * sc + pe * bflo(v.z); acc[8 * t + 5] = acc[8 * t + 5] * sc + pe * bfhi(v.z); acc[8 * t + 6] = acc[8 * t + 6] * sc + pe * bflo(v.w); acc[8 * t + 7] = acc[8 * t + 7] * sc + pe * bfhi(v.w); }
        }
    }
    const float inv = 1.f / lsum; bf16* dst = MX + (size_t)m * 1024 + 512 + hd * 64;
#pragma unroll
    for (int s = 0; s < 8; ++s) { v4u o; o.x = pk2(acc[8 * s] * inv, acc[8 * s + 1] * inv); o.y = pk2(acc[8 * s + 2] * inv, acc[8 * s + 3] * inv); o.z = pk2(acc[8 * s + 4] * inv, acc[8 * s + 5] * inv); o.w = pk2(acc[8 * s + 6] * inv, acc[8 * s + 7] * inv); *(v4u*)(dst + 8 * s) = o; }
}


__device__ __forceinline__ unsigned pkhi(float lo, float hi) { return __builtin_amdgcn_perm(__float_as_uint(hi), __float_as_uint(lo), 0x07060302u); }
#define MFMA16(a, b, c) __builtin_amdgcn_mfma_f32_16x16x32_bf16((a), (b), (c), 0, 0, 0)
struct ATile { int tok0, dstep, C, valid; };
__device__ __forceinline__ ATile attn_tile(int u, int r, int T0, int fr) {
    int d, kt, roff, off, step, tb;
    if (u < 9) { d = 16; kt = u; roff = r; off = 0; step = 1; tb = T0 >> 4; }
    else if (u < 21) { d = 4; kt = u - 9; roff = r & 3; off = r >> 2; step = 4; tb = T0 >> 2; }
    else { d = 1; kt = u - 21; roff = 0; off = r; step = 16; tb = T0; }
    const int base = tb - 128 + 16 * kt;
    ATile t; t.valid = (base >= 0) && (u < 45); const int bb = t.valid ? base : 0;
    t.tok0 = roff + d * bb; t.dstep = d; t.C = off + step * fr + 128 - 16 * kt;
    return t;
}
struct APair { ATile t[2]; int dC; int act; };
__device__ __forceinline__ APair attn_pair(int pr, int w8, int T0, int fr) {
    APair q;
    if (pr < 5) { q.t[0] = attn_tile(2 * pr, w8, T0, fr); q.t[1] = attn_tile(2 * pr + 1 < 9 ? 2 * pr + 1 : 45, w8, T0, fr); q.dC = 0; q.act = 1; }
    else if (pr < 10) { const int k2 = 2 * (pr - 5); q.t[0] = attn_tile(k2, w8 + 8, T0, fr); q.t[1] = attn_tile(k2 + 1 < 9 ? k2 + 1 : 45, w8 + 8, T0, fr); q.dC = 0; q.act = 2; }
    else if (pr < 16) { const int k2 = 9 + 2 * (pr - 10); q.t[0] = attn_tile(k2, w8, T0, fr); q.t[1] = attn_tile(k2 + 1, w8, T0, fr); q.dC = 2; q.act = 3; }
    else { const int k2 = 21 + 2 * (pr - 16); q.t[0] = attn_tile(k2, w8, T0, fr); q.t[1] = attn_tile(k2 + 1, w8, T0, fr); q.dC = 8; q.act = 3; }
    return q;
}
__device__ __forceinline__ void attn_softmax_pv(const bf16x8 (&Kc)[2][2], const bf16x8 (&Qf)[2], const APair& pc, int dC, const bf16x8 (&Vt)[4], float& mrun, float& lrun, f32x4 (&O)[4], int fq, int lane) {
    const float SC = 0.125f * 1.4426950408889634f;
    f32x4 sc[2]; float pm = -3e30f;
#pragma unroll
    for (int h2 = 0; h2 < 2; ++h2) {
        f32x4 z = {0.f, 0.f, 0.f, 0.f};
        z = MFMA16(Kc[h2][0], Qf[0], z); z = MFMA16(Kc[h2][1], Qf[1], z);
        const int c4 = pc.t[h2].C + dC - 4 * fq;
#pragma unroll
        for (int j = 0; j < 4; ++j) { const bool ok = pc.t[h2].valid && ((unsigned)(c4 - j) <= 128u); z[j] = ok ? z[j] : -3e30f; pm = fmaxf(pm, z[j]); }
        sc[h2] = z;
    }
    pm = fmaxf(pm, shflx(pm, 16, lane)); pm = fmaxf(pm, shflx(pm, 32, lane));
    const float mnew = fmaxf(mrun, pm), moff = -mnew * SC;
    float ps = 0.f;
#pragma unroll
    for (int h2 = 0; h2 < 2; ++h2)
#pragma unroll
        for (int j = 0; j < 4; ++j) { sc[h2][j] = __builtin_amdgcn_exp2f(__builtin_fmaf(sc[h2][j], SC, moff)); ps += sc[h2][j]; }
    { const float alpha = __builtin_amdgcn_exp2f((mrun - mnew) * SC); lrun *= alpha;
#pragma unroll
      for (int mt = 0; mt < 4; ++mt) O[mt] = O[mt] * alpha; }
    mrun = mnew; lrun += ps;
    v4u pp; pp.x = cvtpk(sc[0][0], sc[0][1]); pp.y = cvtpk(sc[0][2], sc[0][3]); pp.z = cvtpk(sc[1][0], sc[1][1]); pp.w = cvtpk(sc[1][2], sc[1][3]);
    const bf16x8 Pp = __builtin_bit_cast(bf16x8, pp);
#pragma unroll
    for (int mt = 0; mt < 4; ++mt) O[mt] = MFMA16(Vt[mt], Pp, O[mt]);
}
__device__ __forceinline__ void attn_mfma_unit(CParams p, int unit, int lane, LAS unsigned char* kvl) {
    const int w8 = unit & 7, I = unit >> 9, hd = (unit >> 3) & 7, b = (unit >> 6) & 7, T0 = I * 256, fr = lane & 15, fq = lane >> 4;
    const bf16* Bq = (const bf16*)(((unsigned char*)p->ws) + WS_BQKV); bf16* MX = (bf16*)((float*)p->out);
    const bf16* rowb = Bq + (size_t)b * SEQ * 1536 + hd * 64 + 8 * fq;
    const int qtokA = T0 + w8 + 16 * fr, qtokB = qtokA + 8;
    bf16x8 Qa[2], Qb[2];
    Qa[0] = *(const bf16x8*)(rowb + (size_t)qtokA * 1536); Qa[1] = *(const bf16x8*)(rowb + (size_t)qtokA * 1536 + 32);
    Qb[0] = *(const bf16x8*)(rowb + (size_t)qtokB * 1536); Qb[1] = *(const bf16x8*)(rowb + (size_t)qtokB * 1536 + 32);
    bf16x8 Sel[2];
#pragma unroll
    for (int c = 0; c < 2; ++c)
#pragma unroll
        for (int j = 0; j < 8; ++j) Sel[c][j] = (8 * fq + j == 16 * c + fr) ? (short)0x3F80 : (short)0;
    f32x4 Oa[4], Ob[4];
#pragma unroll
    for (int mt = 0; mt < 4; ++mt) { Oa[mt] = (f32x4){0.f, 0.f, 0.f, 0.f}; Ob[mt] = (f32x4){0.f, 0.f, 0.f, 0.f}; }
    float mA = -1e30f, lA = 0.f, mB = -1e30f, lB = 0.f;
    bf16x8 Kc[2][2], Vc[2][2], Kn[2][2], Vn[2][2];
    APair pc = attn_pair(0, w8, T0, fr), pn = pc;
#pragma unroll
    for (int h2 = 0; h2 < 2; ++h2) { const bf16* kp = rowb + (size_t)(pc.t[h2].tok0 + pc.t[h2].dstep * fr) * 1536 + 512;
        Kc[h2][0] = *(const bf16x8*)kp; Kc[h2][1] = *(const bf16x8*)(kp + 32); Vc[h2][0] = *(const bf16x8*)(kp + 512); Vc[h2][1] = *(const bf16x8*)(kp + 544); }
#pragma unroll 1
    for (int pr = 0; pr < 28; ++pr) {
        if (pr + 1 < 16) { pn = attn_pair(pr + 1, w8, T0, fr);
#pragma unroll
            for (int h2 = 0; h2 < 2; ++h2) { const bf16* kp = rowb + (size_t)(pn.t[h2].tok0 + pn.t[h2].dstep * fr) * 1536 + 512;
                Kn[h2][0] = *(const bf16x8*)kp; Kn[h2][1] = *(const bf16x8*)(kp + 32); Vn[h2][0] = *(const bf16x8*)(kp + 512); Vn[h2][1] = *(const bf16x8*)(kp + 544); }
        } else if (pr + 1 < 28) { pn = attn_pair(pr + 1, w8, T0, fr);
#pragma unroll
            for (int h2 = 0; h2 < 2; ++h2) { LAS unsigned char* kp = kvl + (16 * (2 * (pr + 1 - 16) + h2) + fr) * 272 + fq * 16;
                Kn[h2][0] = *(const LAS bf16x8*)kp; Kn[h2][1] = *(const LAS bf16x8*)(kp + 64); Vn[h2][0] = *(const LAS bf16x8*)(kp + 128); Vn[h2][1] = *(const LAS bf16x8*)(kp + 192); }
        }
        if (pc.t[0].valid | pc.t[1].valid) {
        bf16x8 Vt[4];
#pragma unroll
        for (int mt = 0; mt < 4; ++mt) {
            const f32x4 z = {0.f, 0.f, 0.f, 0.f};
            const f32x4 va = MFMA16(Vc[0][mt >> 1], Sel[mt & 1], z), vb = MFMA16(Vc[1][mt >> 1], Sel[mt & 1], z);
            v4u vp; vp.x = pkhi(va[0], va[1]); vp.y = pkhi(va[2], va[3]); vp.z = pkhi(vb[0], vb[1]); vp.w = pkhi(vb[2], vb[3]);
            Vt[mt] = __builtin_bit_cast(bf16x8, vp);
        }
        if (pc.act & 1) attn_softmax_pv(Kc, Qa, pc, 0, Vt, mA, lA, Oa, fq, lane);
        if (pc.act & 2) attn_softmax_pv(Kc, Qb, pc, pc.dC, Vt, mB, lB, Ob, fq, lane);
        }
        pc = pn;
#pragma unroll
        for (int h2 = 0; h2 < 2; ++h2) { Kc[h2][0] = Kn[h2][0]; Kc[h2][1] = Kn[h2][1]; Vc[h2][0] = Vn[h2][0]; Vc[h2][1] = Vn[h2][1]; }
    }
    lA += shflx(lA, 16, lane); lA += shflx(lA, 32, lane); lB += shflx(lB, 16, lane); lB += shflx(lB, 32, lane);
    const float ia = 1.f / lA, ib = 1.f / lB;
    bf16* dA = MX + (size_t)(b * SEQ + qtokA) * 1024 + 512 + hd * 64 + 4 * fq; bf16* dB = dA + (size_t)8 * 1024;
#pragma unroll
    for (int mt = 0; mt < 4; ++mt) { v2u o; o.x = cvtpk(Oa[mt][0] * ia, Oa[mt][1] * ia); o.y = cvtpk(Oa[mt][2] * ia, Oa[mt][3] * ia); *(v2u*)(dA + 16 * mt) = o;
        v2u o2; o2.x = cvtpk(Ob[mt][0] * ib, Ob[mt][1] * ib); o2.y = cvtpk(Ob[mt][2] * ib, Ob[mt][3] * ib); *(v2u*)(dB + 16 * mt) = o2; }
}


__device__ __forceinline__ void attn_stage(CParams p, const Ctx cx, int bu, LAS unsigned char* kvl) {
    const int I = bu >> 6, hd = bu & 7, b = (bu >> 3) & 7, T0 = I * 256;
    const bf16* Bq = (const bf16*)(((unsigned char*)p->ws) + WS_BQKV) + (size_t)b * SEQ * 1536 + 512 + hd * 64;
    __syncthreads();
    v4u st[12];
#pragma unroll
    for (int r = 0; r < 12; ++r) { const int idx = cx.tid + NTHR * r, row = idx >> 4, seg = idx & 15, tok = T0 - 128 + row;
        st[r] = (v4u){0u, 0u, 0u, 0u};
        if (tok >= 0) st[r] = *(const v4u*)(Bq + (size_t)tok * 1536 + (seg < 8 ? seg * 8 : 512 + (seg - 8) * 8)); }
#pragma unroll
    for (int r = 0; r < 12; ++r) { const int idx = cx.tid + NTHR * r; *(LAS v4u*)(kvl + (idx >> 4) * 272 + (idx & 15) * 16) = st[r]; }
    __syncthreads();
}

constexpr size_t WS_UT = 224 * MiB, WS_WM = 256 * MiB, WS_KT = 288 * MiB, WS_QKM = 416 * MiB, WS_GC = 432 * MiB, WS_ORAW = 440 * MiB;
#define D1_ROWPTR(un_, r_) (((const bf16*)(((unsigned char*)p->ws) + WS_QKVN)) + (size_t)((((un_) >> 6) >> 2) * SEQ + ((un_) & 63) * 64 + (((cx.tid + NTHR * (r_)) & 1023) >> 4)) * 1536 + ((cx.tid + NTHR * (r_)) >> 10) * 512 + (((un_) >> 6) & 3) * 128 + ((cx.tid + NTHR * (r_)) & 15) * 8)
__device__ __forceinline__ void d1_unit(CParams p, const Ctx cx, int unit, int next_unit, v4u& pf0, v4u& pf1, v4u& pf2, v4u& pf3, v4u& pf4, v4u& pf5, LAS unsigned char* lds, int wave, int lane) {
    const int tid = cx.tid, c = unit & 63, bh = unit >> 6, b = bh >> 2, h = bh & 3, mbase = b * SEQ + c * 64, fr = lane & 15, fq = lane >> 4;
    const bf16* Q = (const bf16*)(((unsigned char*)p->ws) + WS_QKVN); const float* Gt = (const float*)(((unsigned char*)p->ws) + WS_GATES);
    LAS unsigned char* qs = lds; LAS unsigned char* ks = lds + 17408; LAS unsigned char* vs = lds + 34816;
    LAS float* Am = (LAS float*)(lds + 51200); LAS float* gG = (LAS float*)(lds + 67584); LAS float* gB = gG + 64; LAS float* gE = gG + 128;
    float g = 0.f, be = 0.f;
    if (tid < 64) { g = Gt[(size_t)(mbase + tid) * 8 + 4 + h]; be = Gt[(size_t)(mbase + tid) * 8 + h]; }
    __syncthreads();
    { const v4u pv[6] = {pf0, pf1, pf2, pf3, pf4, pf5};
#pragma unroll
      for (int r = 0; r < 6; ++r) { const int idx = tid + NTHR * r, mat = idx >> 10, rem = idx & 1023, tk = rem >> 4, seg = rem & 15;
        *(LAS v4u*)(lds + (mat == 2 ? 34816 + tk * 256 : mat * 17408 + tk * 272) + seg * 16) = pv[r]; } }
    if (tid < 64) {
#pragma unroll
        for (int o = 1; o < 64; o <<= 1) { const float t = shflx(g, 0, lane - o < 0 ? lane : lane - o); if (lane >= o) g += t; }
        const float glast = __builtin_bit_cast(float, __builtin_amdgcn_readlane(__builtin_bit_cast(int, g), 63));
        gG[tid] = g; gB[tid] = be; gE[tid] = __expf(g);
        float* gc = (float*)(((unsigned char*)p->ws) + WS_GC) + (size_t)unit * 128; gc[tid] = __expf(g); gc[64 + tid] = __expf(glast - g);
    }
    __syncthreads();
    {
        const int mat = wave >> 2, tm = wave & 3;
        LAS unsigned char* asrc = (mat ? qs : ks) + (16 * tm + fr) * 272 + fq * 16;
        bf16x8 af[4];
#pragma unroll
        for (int s4 = 0; s4 < 4; ++s4) af[s4] = *(const LAS bf16x8*)(asrc + s4 * 64);
        float Gi[4], Bi[4];
#pragma unroll
        for (int j = 0; j < 4; ++j) { Gi[j] = gG[16 * tm + 4 * fq + j]; Bi[j] = gB[16 * tm + 4 * fq + j]; }
#pragma unroll
        for (int tn = 0; tn < 4; ++tn) {
            f32x4 acc = {0.f, 0.f, 0.f, 0.f};
#pragma unroll
            for (int s4 = 0; s4 < 4; ++s4) { const bf16x8 bfr = *(const LAS bf16x8*)(ks + (16 * tn + fr) * 272 + fq * 16 + s4 * 64); acc = MFMA16(af[s4], bfr, acc); }
            const int jj = 16 * tn + fr; const float Gj = gG[jj];
#pragma unroll
            for (int j = 0; j < 4; ++j) { const int ii = 16 * tm + 4 * fq + j; const float e = __expf(fminf(Gi[j] - Gj, 0.f));
                if (mat == 0) Am[jj * 64 + ii] = (ii > jj) ? Bi[j] * acc[j] * e : 0.f;
                else *(LAS unsigned short*)(lds + 134144 + (ii * 64 + jj) * 2) = (unsigned short)f2bf((ii >= jj) ? acc[j] * e : 0.f); }
        }
    }
    __syncthreads();
    if (tid < 256) {
        const int cc = tid & 127; const bool isw = tid >= 128;
        LAS float* xs = (LAS float*)(lds + 68608);
#pragma unroll 1
        for (int blk = 0; blk < 4; ++blk) {
            float acc[16];
#pragma unroll
            for (int r = 0; r < 16; ++r) { const int i = 16 * blk + r;
                const unsigned short raw = isw ? *(const LAS unsigned short*)(ks + i * 272 + cc * 2) : *(const LAS unsigned short*)(vs + i * 256 + cc * 2);
                float a = __uint_as_float((unsigned)raw << 16) * gB[i]; if (isw) a *= gE[i]; acc[r] = a; }
#pragma unroll 4
            for (int j = 0; j < 16 * blk; ++j) { const float xj = xs[j * 256 + tid]; const LAS f32x4* at = (const LAS f32x4*)(Am + j * 64 + 16 * blk);
#pragma unroll
                for (int q = 0; q < 4; ++q) { const f32x4 t = at[q]; acc[4 * q] -= t.x * xj; acc[4 * q + 1] -= t.y * xj; acc[4 * q + 2] -= t.z * xj; acc[4 * q + 3] -= t.w * xj; } }
#pragma unroll
            for (int r2 = 0; r2 < 15; ++r2) { const float xr = acc[r2]; const LAS float* row = Am + (16 * blk + r2) * 64 + 16 * blk;
#pragma unroll
                for (int q = (r2 + 1) / 4; q < 4; ++q) { const f32x4 t = *(const LAS f32x4*)(row + 4 * q);
                    if (4 * q + 0 > r2) acc[4 * q + 0] -= t.x * xr; if (4 * q + 1 > r2) acc[4 * q + 1] -= t.y * xr; if (4 * q + 2 > r2) acc[4 * q + 2] -= t.z * xr; if (4 * q + 3 > r2) acc[4 * q + 3] -= t.w * xr; } }
#pragma unroll
            for (int r = 0; r < 16; ++r) xs[(16 * blk + r) * 256 + tid] = acc[r];
        }
    } else {
        const int t2 = tid - 256, dk = t2 & 127, g2 = t2 >> 7; bf16* kt = (bf16*)(((unsigned char*)p->ws) + WS_KT) + (size_t)unit * 8192 + dk * 64 + 32 * g2;
#pragma unroll
        for (int q8 = 0; q8 < 4; ++q8) { unsigned short e[8];
#pragma unroll
            for (int t = 0; t < 8; ++t) e[t] = *(const LAS unsigned short*)(ks + (32 * g2 + 8 * q8 + t) * 272 + dk * 2);
            v4u o; o.x = e[0] | ((unsigned)e[1] << 16); o.y = e[2] | ((unsigned)e[3] << 16); o.z = e[4] | ((unsigned)e[5] << 16); o.w = e[6] | ((unsigned)e[7] << 16); *(v4u*)(kt + 8 * q8) = o; }
    }
    if (next_unit >= 0) { pf0 = *(const v4u*)D1_ROWPTR(next_unit, 0); pf1 = *(const v4u*)D1_ROWPTR(next_unit, 1); pf2 = *(const v4u*)D1_ROWPTR(next_unit, 2); pf3 = *(const v4u*)D1_ROWPTR(next_unit, 3); pf4 = *(const v4u*)D1_ROWPTR(next_unit, 4); pf5 = *(const v4u*)D1_ROWPTR(next_unit, 5); }
    __syncthreads();
    {
        const LAS float* xs = (const LAS float*)(lds + 68608);
        bf16* wm = (bf16*)(((unsigned char*)p->ws) + WS_WM) + (size_t)unit * 8192; bf16* ut = (bf16*)(((unsigned char*)p->ws) + WS_UT) + (size_t)unit * 8192;
#pragma unroll
        for (int r2 = 0; r2 < 2; ++r2) { const int idx = tid + NTHR * r2, i = idx >> 4, seg = idx & 15;
            const f32x4 a0 = *(const LAS f32x4*)(xs + i * 256 + 128 + seg * 8), a1 = *(const LAS f32x4*)(xs + i * 256 + 128 + seg * 8 + 4);
            v4u o; o.x = cvtpk(a0.x, a0.y); o.y = cvtpk(a0.z, a0.w); o.z = cvtpk(a1.x, a1.y); o.w = cvtpk(a1.z, a1.w); *(v4u*)(wm + i * 128 + seg * 8) = o; }
#pragma unroll
        for (int r2 = 0; r2 < 2; ++r2) { const int idx = tid + NTHR * r2, dv = idx >> 3, seg = idx & 7; float e[8];
#pragma unroll
            for (int t = 0; t < 8; ++t) e[t] = xs[(seg * 8 + t) * 256 + dv];
            v4u o; o.x = cvtpk(e[0], e[1]); o.y = cvtpk(e[2], e[3]); o.z = cvtpk(e[4], e[5]); o.w = cvtpk(e[6], e[7]); *(v4u*)(ut + dv * 64 + seg * 8) = o; }
        { const v4u q = *(const LAS v4u*)(lds + 134144 + tid * 16); *(v4u*)((bf16*)(((unsigned char*)p->ws) + WS_QKM) + (size_t)unit * 4096 + tid * 8) = q; }
    }
}

__device__ __forceinline__ bf16x8 ldfrag8(LAS unsigned char* pa) { const v2u a = *(const LAS v2u*)pa, b = *(const LAS v2u*)(pa + 32); v4u r; r.x = a.x; r.y = a.y; r.z = b.x; r.w = b.y; return __builtin_bit_cast(bf16x8, r); }
__device__ __forceinline__ void scan_chunked_unit(CParams p, const Ctx cx, int l, int bh, LAS unsigned char* lds, int wave, int lane) {
    const int tid = cx.tid, b = bh >> 2, h = bh & 3, fr = lane & 15, fq = lane >> 4;
    const bf16* Q = (const bf16*)(((unsigned char*)p->ws) + WS_QKVN); bf16* OR = (bf16*)(((unsigned char*)p->ws) + WS_ORAW);
    const bf16* Wm = (const bf16*)(((unsigned char*)p->ws) + WS_WM); const bf16* KT = (const bf16*)(((unsigned char*)p->ws) + WS_KT); const bf16* UT = (const bf16*)(((unsigned char*)p->ws) + WS_UT); const bf16* QKm = (const bf16*)(((unsigned char*)p->ws) + WS_QKM);
    const float* Gc = (const float*)(((unsigned char*)p->ws) + WS_GC);
    constexpr int BUF = 61440, O_W = 0, O_Q = 17408, O_KT = 34816, O_QK = 52224, O_G = 2 * BUF, O_OT = 2 * BUF + 1024;
    f32x4 Sacc[8];
#pragma unroll
    for (int dt = 0; dt < 8; ++dt) Sacc[dt] = (f32x4){0.f, 0.f, 0.f, 0.f};
    v4u st[7]; float gst = 0.f;
    __syncthreads();
#define SCAN_LOAD(ch) do { const size_t un = (size_t)bh * 64 + (ch); const int mb = b * SEQ + (ch) * 64; \
        _Pragma("unroll") for (int r = 0; r < 7; ++r) { const int idx = tid + NTHR * r; const bf16* src; \
            if (r < 2) src = Wm + un * 8192 + (idx >> 4) * 128 + (idx & 15) * 8; \
            else if (r < 4) src = Q + (size_t)(mb + ((idx - 1024) >> 4)) * 1536 + h * 128 + (idx & 15) * 8; \
            else if (r < 6) src = KT + un * 8192 + ((idx - 2048) >> 3) * 64 + (idx & 7) * 8; \
            else src = QKm + un * 4096 + ((idx - 3072) >> 3) * 64 + (idx & 7) * 8; \
            st[r] = *(const v4u*)src; } \
        if (tid < 128) gst = Gc[un * 128 + tid]; } while (0)
#define SCAN_STORE(par) do { LAS unsigned char* bb = lds + (par) * BUF; \
        _Pragma("unroll") for (int r = 0; r < 7; ++r) { const int idx = tid + NTHR * r; int off; \
            if (r < 2) off = O_W + (idx >> 4) * 272 + (idx & 15) * 16; \
            else if (r < 4) off = O_Q + ((idx - 1024) >> 4) * 272 + (idx & 15) * 16; \
            else if (r < 6) off = O_KT + ((idx - 2048) >> 3) * 136 + (idx & 7) * 16; \
            else off = O_QK + ((idx - 3072) >> 3) * 136 + (idx & 7) * 16; \
            *(LAS v4u*)(bb + off) = st[r]; } \
        if (tid < 128) ((LAS float*)(lds + O_G))[(par) * 128 + tid] = gst; } while (0)
    SCAN_LOAD(0); SCAN_STORE(0);
    v2u uun[4];
#pragma unroll
    for (int tm = 0; tm < 4; ++tm) uun[tm] = *(const v2u*)(UT + (size_t)bh * 64 * 8192 + (16 * wave + fr) * 64 + 16 * tm + 4 * fq);
    const int ftk = tid >> 3, fsub = tid & 7;
    __syncthreads();
    for (int ch = 0; ch < SEQ / 64; ++ch) {
        const int par = ch & 1, mb = b * SEQ + ch * 64; const size_t un = (size_t)bh * 64 + ch;
        LAS unsigned char* bb = lds + par * BUF;
        if (ch + 1 < SEQ / 64) SCAN_LOAD(ch + 1);
        v2u uu[4];
#pragma unroll
        for (int tm = 0; tm < 4; ++tm) uu[tm] = uun[tm];
        if (ch + 1 < SEQ / 64) {
#pragma unroll
            for (int tm = 0; tm < 4; ++tm) uun[tm] = *(const v2u*)(UT + (un + 1) * 8192 + (16 * wave + fr) * 64 + 16 * tm + 4 * fq);
        }
        const LAS float* Gs = (const LAS float*)(lds + O_G) + par * 128;
        const float dc = Gs[63];
        bf16x8 Sb[4];
#pragma unroll
        for (int s4 = 0; s4 < 4; ++s4) { v4u t; t.x = cvtpk(Sacc[2 * s4][0], Sacc[2 * s4][1]); t.y = cvtpk(Sacc[2 * s4][2], Sacc[2 * s4][3]); t.z = cvtpk(Sacc[2 * s4 + 1][0], Sacc[2 * s4 + 1][1]); t.w = cvtpk(Sacc[2 * s4 + 1][2], Sacc[2 * s4 + 1][3]); Sb[s4] = __builtin_bit_cast(bf16x8, t); }
        f32x4 VN[4], OO[4];
#pragma unroll
        for (int tm = 0; tm < 4; ++tm) {
            f32x4 ws_ = {0.f, 0.f, 0.f, 0.f}, qs_ = {0.f, 0.f, 0.f, 0.f};
#pragma unroll
            for (int s4 = 0; s4 < 4; ++s4) { ws_ = MFMA16(ldfrag8(bb + O_W + (16 * tm + fr) * 272 + 64 * s4 + 8 * fq), Sb[s4], ws_);
                                              qs_ = MFMA16(ldfrag8(bb + O_Q + (16 * tm + fr) * 272 + 64 * s4 + 8 * fq), Sb[s4], qs_); }
            const float u0 = bflo(uu[tm].x), u1 = bfhi(uu[tm].x), u2 = bflo(uu[tm].y), u3 = bfhi(uu[tm].y);
            VN[tm] = (f32x4){u0 - ws_[0], u1 - ws_[1], u2 - ws_[2], u3 - ws_[3]};
#pragma unroll
            for (int j = 0; j < 4; ++j) OO[tm][j] = qs_[j] * Gs[16 * tm + 4 * fq + j];
        }
        bf16x8 Vb[2], Vd[2];
#pragma unroll
        for (int s2 = 0; s2 < 2; ++s2) {
            v4u t; t.x = cvtpk(VN[2 * s2][0], VN[2 * s2][1]); t.y = cvtpk(VN[2 * s2][2], VN[2 * s2][3]); t.z = cvtpk(VN[2 * s2 + 1][0], VN[2 * s2 + 1][1]); t.w = cvtpk(VN[2 * s2 + 1][2], VN[2 * s2 + 1][3]); Vb[s2] = __builtin_bit_cast(bf16x8, t);
            float e[8];
#pragma unroll
            for (int j = 0; j < 8; ++j) e[j] = Gs[64 + 16 * (2 * s2 + (j >> 2)) + 4 * fq + (j & 3)];
            v4u d; d.x = cvtpk(VN[2 * s2][0] * e[0], VN[2 * s2][1] * e[1]); d.y = cvtpk(VN[2 * s2][2] * e[2], VN[2 * s2][3] * e[3]); d.z = cvtpk(VN[2 * s2 + 1][0] * e[4], VN[2 * s2 + 1][1] * e[5]); d.w = cvtpk(VN[2 * s2 + 1][2] * e[6], VN[2 * s2 + 1][3] * e[7]); Vd[s2] = __builtin_bit_cast(bf16x8, d);
        }
#pragma unroll
        for (int tm = 0; tm < 4; ++tm)
#pragma unroll
            for (int s2 = 0; s2 < 2; ++s2) OO[tm] = MFMA16(ldfrag8(bb + O_QK + (16 * tm + fr) * 136 + 64 * s2 + 8 * fq), Vb[s2], OO[tm]);
#pragma unroll
        for (int dt = 0; dt < 8; ++dt) { Sacc[dt] = Sacc[dt] * dc;
#pragma unroll
            for (int s2 = 0; s2 < 2; ++s2) Sacc[dt] = MFMA16(ldfrag8(bb + O_KT + (16 * dt + fr) * 136 + 64 * s2 + 8 * fq), Vd[s2], Sacc[dt]); }
        LAS float* Ot = (LAS float*)(lds + O_OT);
#pragma unroll
        for (int tm = 0; tm < 4; ++tm)
#pragma unroll
            for (int j = 0; j < 4; ++j) Ot[(16 * tm + 4 * fq + j) * 128 + 16 * wave + fr] = OO[tm][j];
        if (ch + 1 < SEQ / 64) SCAN_STORE(par ^ 1);
        __syncthreads();
        {
            float ov[16];
#pragma unroll
            for (int q4 = 0; q4 < 4; ++q4) { const f32x4 t = *(const LAS f32x4*)(Ot + ftk * 128 + fsub * 16 + q4 * 4); ov[4 * q4] = t.x; ov[4 * q4 + 1] = t.y; ov[4 * q4 + 2] = t.z; ov[4 * q4 + 3] = t.w; }
            v4u o0, o1; o0.x = cvtpk(ov[0], ov[1]); o0.y = cvtpk(ov[2], ov[3]); o0.z = cvtpk(ov[4], ov[5]); o0.w = cvtpk(ov[6], ov[7]); o1.x = cvtpk(ov[8], ov[9]); o1.y = cvtpk(ov[10], ov[11]); o1.z = cvtpk(ov[12], ov[13]); o1.w = cvtpk(ov[14], ov[15]);
            bf16* dst = OR + (size_t)(mb + ftk) * 512 + h * 128 + fsub * 16; *(v4u*)dst = o0; *(v4u*)(dst + 8) = o1;
        }
        __syncthreads();
    }
#undef SCAN_LOAD
#undef SCAN_STORE
}


__device__ __forceinline__ void gate_phase(CParams p, const Ctx cx, int l, int wave, int lane) {
    const bf16* OR = (const bf16*)(((unsigned char*)p->ws) + WS_ORAW); const bf16* Z = (const bf16*)(((unsigned char*)p->ws) + WS_Z); bf16* MX = (bf16*)((float*)p->out);
    const int gw = cx.bx * NWAVES + wave, NGW = gridDim.x * NWAVES, sub = lane & 15, rl = lane >> 4;
    float wn[8];
#pragma unroll
    for (int e = 0; e < 8; ++e) wn[e] = ((const float*)p->dn_out_norm)[l * 128 + 8 * sub + e];
    constexpr int RB = 4;
    for (int itb = gw; itb < M; itb += NGW * RB) {
        v4u oa[RB], za[RB];
#pragma unroll
        for (int q = 0; q < RB; ++q) { const size_t off = (size_t)(itb + q * NGW) * 512 + rl * 128 + 8 * sub; oa[q] = *(const v4u*)(OR + off); za[q] = *(const v4u*)(Z + off); }
#pragma unroll
        for (int q = 0; q < RB; ++q) {
            const float o[8] = {bflo(oa[q].x), bfhi(oa[q].x), bflo(oa[q].y), bfhi(oa[q].y), bflo(oa[q].z), bfhi(oa[q].z), bflo(oa[q].w), bfhi(oa[q].w)};
            const float z[8] = {bflo(za[q].x), bfhi(za[q].x), bflo(za[q].y), bfhi(za[q].y), bflo(za[q].z), bfhi(za[q].z), bflo(za[q].w), bfhi(za[q].w)};
            float ss = 0.f;
#pragma unroll
            for (int e = 0; e < 8; ++e) ss += o[e] * o[e];
            ss += DPP_F(ss, 0xB1); ss += DPP_F(ss, 0x4E); ss += DPP_F(ss, 0x141); ss += DPP_F(ss, 0x140);
            const float rstd = rsqrtf(ss * (1.f / 128.f) + EPS);
            float r[8];
#pragma unroll
            for (int e = 0; e < 8; ++e) r[e] = o[e] * rstd * wn[e] * silu_f(z[e]);
            v4u w; w.x = cvtpk(r[0], r[1]); w.y = cvtpk(r[2], r[3]); w.z = cvtpk(r[4], r[5]); w.w = cvtpk(r[6], r[7]);
            *(v4u*)(MX + (size_t)(itb + q * NGW) * 1024 + rl * 128 + 8 * sub) = w;
        }
    }
}

__device__ __forceinline__ float gelu_tanh_f(float x) { const float z = 0.7978845608028654f * (x + 0.044715f * x * x * x); return x * __builtin_amdgcn_rcpf(1.f + __expf(-2.f * z)); }
__device__ __forceinline__ void ffn_conv_phase(CParams p, const Ctx cx, int l, int hf) {
    const bf16* U = (const bf16*)(((unsigned char*)p->ws) + WS_U); bf16* ACT = (bf16*)(((unsigned char*)p->ws) + WS_ACT);
    const float* cw = ((const float*)p->ffn_conv) + (size_t)l * 3 * DFF2; const float* cb = ((const float*)p->ffn_conv_bias) + (size_t)l * DFF2;
    const int hw = hf ? 1280 : 1536, coff = hf ? 1536 : 0, ncg = hw / 8, ldu = 2 * hw;
    for (int it = cx.bx * NTHR + cx.tid; it < (M / 16) * ncg; it += gridDim.x * NTHR) {
        const int cgp = it % ncg, rr = it / ncg, m0 = rr * 16, c0 = cgp * 8, pos0 = m0 & (SEQ - 1), gc = coff + c0;
        float wg[3][8], wv[3][8], bg[8], bv[8], pg[2][8], pv[2][8];
#pragma unroll
        for (int j = 0; j < 3; ++j)
#pragma unroll
            for (int e = 0; e < 8; ++e) { wg[j][e] = cw[j * DFF2 + gc + e]; wv[j][e] = cw[j * DFF2 + DFF + gc + e]; }
#pragma unroll
        for (int e = 0; e < 8; ++e) { bg[e] = cb[gc + e]; bv[e] = cb[DFF + gc + e]; }
#pragma unroll
        for (int k = 0; k < 2; ++k) {
            v4u a = {0u, 0u, 0u, 0u}, b = {0u, 0u, 0u, 0u};
            if (pos0 > 0) { a = *(const v4u*)(U + (size_t)(m0 - 2 + k) * ldu + c0); b = *(const v4u*)(U + (size_t)(m0 - 2 + k) * ldu + hw + c0); }
            pg[k][0] = bflo(a.x); pg[k][1] = bfhi(a.x); pg[k][2] = bflo(a.y); pg[k][3] = bfhi(a.y); pg[k][4] = bflo(a.z); pg[k][5] = bfhi(a.z); pg[k][6] = bflo(a.w); pg[k][7] = bfhi(a.w);
            pv[k][0] = bflo(b.x); pv[k][1] = bfhi(b.x); pv[k][2] = bflo(b.y); pv[k][3] = bfhi(b.y); pv[k][4] = bflo(b.z); pv[k][5] = bfhi(b.z); pv[k][6] = bflo(b.w); pv[k][7] = bfhi(b.w);
        }
#pragma unroll 1
        for (int rb = 0; rb < 16; rb += 8) {
            v4u la[8], lb[8];
#pragma unroll
            for (int r = 0; r < 8; ++r) { const int m = m0 + rb + r; la[r] = *(const v4u*)(U + (size_t)m * ldu + c0); lb[r] = *(const v4u*)(U + (size_t)m * ldu + hw + c0); }
#pragma unroll
            for (int r = 0; r < 8; ++r) {
                const int m = m0 + rb + r; const v4u a = la[r], b = lb[r];
                const float cg_[8] = {bflo(a.x), bfhi(a.x), bflo(a.y), bfhi(a.y), bflo(a.z), bfhi(a.z), bflo(a.w), bfhi(a.w)};
                const float cv_[8] = {bflo(b.x), bfhi(b.x), bflo(b.y), bfhi(b.y), bflo(b.z), bfhi(b.z), bflo(b.w), bfhi(b.w)};
                float o[8];
#pragma unroll
                for (int e = 0; e < 8; ++e) {
                    const float gt = wg[0][e] * pg[0][e] + wg[1][e] * pg[1][e] + wg[2][e] * cg_[e] + bg[e];
                    const float vl = wv[0][e] * pv[0][e] + wv[1][e] * pv[1][e] + wv[2][e] * cv_[e] + bv[e];
                    o[e] = gelu_tanh_f(gt) * vl;
                    pg[0][e] = pg[1][e]; pg[1][e] = cg_[e]; pv[0][e] = pv[1][e]; pv[1][e] = cv_[e];
                }
                v4u w; w.x = pk2(o[0], o[1]); w.y = pk2(o[2], o[3]); w.z = pk2(o[4], o[5]); w.w = pk2(o[6], o[7]);
                *(v4u*)(ACT + (size_t)m * DFF + coff + c0) = w;
            }
        }
    }
}


__device__ __forceinline__ void ffn_fixup(CParams p, const Ctx cx, int l, int pm) {
    const bf16* HL = (const bf16*)(((unsigned char*)p->ws) + ((size_t)440 << 20)); bf16* ACT = (bf16*)(((unsigned char*)p->ws) + WS_ACT);
    const float* cw = ((const float*)p->ffn_conv) + (size_t)l * 3 * DFF2; const float* cb = ((const float*)p->ffn_conv_bias) + (size_t)l * DFF2;
    for (int it = cx.tid; it < 4 * 352; it += NTHR) {
        const int si = it / 352, cgp = it % 352, pn = cgp >> 4, c0 = (cgp & 15) * 8, strip = pm * 4 + si, gc = pn * 128 + c0, colp = pn * 256 + c0;
        const bool first = ((strip * 64) & (SEQ - 1)) == 0;
        float ug[4][8], uv[4][8];
#pragma unroll
        for (int rr = 0; rr < 4; ++rr) {
            v4u a = {0u, 0u, 0u, 0u}, b = {0u, 0u, 0u, 0u};
            if (rr >= 2) { a = *(const v4u*)(HL + ((size_t)strip * 4 + (rr - 2)) * 5632 + colp); b = *(const v4u*)(HL + ((size_t)strip * 4 + (rr - 2)) * 5632 + colp + 128); }
            else if (!first) { a = *(const v4u*)(HL + ((size_t)(strip - 1) * 4 + 2 + rr) * 5632 + colp); b = *(const v4u*)(HL + ((size_t)(strip - 1) * 4 + 2 + rr) * 5632 + colp + 128); }
            ug[rr][0] = bflo(a.x); ug[rr][1] = bfhi(a.x); ug[rr][2] = bflo(a.y); ug[rr][3] = bfhi(a.y); ug[rr][4] = bflo(a.z); ug[rr][5] = bfhi(a.z); ug[rr][6] = bflo(a.w); ug[rr][7] = bfhi(a.w);
            uv[rr][0] = bflo(b.x); uv[rr][1] = bfhi(b.x); uv[rr][2] = bflo(b.y); uv[rr][3] = bfhi(b.y); uv[rr][4] = bflo(b.z); uv[rr][5] = bfhi(b.z); uv[rr][6] = bflo(b.w); uv[rr][7] = bfhi(b.w);
        }
#pragma unroll
        for (int ro = 0; ro < 2; ++ro) {
            float o[8];
#pragma unroll
            for (int e = 0; e < 8; ++e) {
                const float g = cw[gc + e] * ug[ro][e] + cw[DFF2 + gc + e] * ug[ro + 1][e] + cw[2 * DFF2 + gc + e] * ug[ro + 2][e] + cb[gc + e];
                const float v = cw[DFF + gc + e] * uv[ro][e] + cw[DFF2 + DFF + gc + e] * uv[ro + 1][e] + cw[2 * DFF2 + DFF + gc + e] * uv[ro + 2][e] + cb[DFF + gc + e];
                o[e] = gelu_tanh_f(g) * v;
            }
            v4u w; w.x = pk2(o[0], o[1]); w.y = pk2(o[2], o[3]); w.z = pk2(o[4], o[5]); w.w = pk2(o[6], o[7]);
            *(v4u*)(ACT + (size_t)(strip * 64 + ro) * DFF + gc) = w;
        }
    }
}

#define XB_TMO      128
#define XB_XCNT(j)  (256  + 64 * (j))
#define XB_XSUB(j)  (1280 + 64 * (j))
#define XB_XGEN(j)  (2304 + 64 * (j))
#define XB_TOP      3328
#define XB_TOPGEN   3392
#define XCD_BAR_WORDS 3456
#define XB_SPIN_CAP (1u << 22)

__device__ __forceinline__ unsigned xb_ld(unsigned* p)              { return __hip_atomic_load(p, __ATOMIC_RELAXED, __HIP_MEMORY_SCOPE_AGENT); }
__device__ __forceinline__ unsigned xb_add(unsigned* p, unsigned v) { return __hip_atomic_fetch_add(p, v, __ATOMIC_RELAXED, __HIP_MEMORY_SCOPE_AGENT); }
__device__ __forceinline__ unsigned xb_xcc_id() { return (unsigned)__builtin_amdgcn_s_getreg((3 << 11) | 20) & 0xFu; }
#define XB_SPIN(cond, bar) do { unsigned _sp = 0; while (cond) { __builtin_amdgcn_s_sleep(1); \
    if ((++_sp & 255u) == 0u) { if (xb_ld(&(bar)[XB_TMO])) break; if (_sp > XB_SPIN_CAP) { atomicAdd(&(bar)[XB_TMO], 1u); break; } } } } while (0)

struct XcdBarrier {
    unsigned* bar; unsigned x;
    volatile LAS unsigned* st;
};

__device__ __forceinline__ XcdBarrier xcd_barrier_post(unsigned* bar, volatile LAS unsigned* st) {
    XcdBarrier b; b.bar = bar; b.x = xb_xcc_id(); b.st = st;
    if (threadIdx.x == 0) (void)xb_add(&bar[XB_XCNT(b.x)], 1u);
    return b;
}
__device__ __forceinline__ void xcd_barrier_complete(unsigned* bar, unsigned x, unsigned& nloc, unsigned& nx) {
    const unsigned G = gridDim.x * gridDim.y * gridDim.z;
    unsigned sum, cnt, mine, sp = 0u;
    for (;;) {
        sum = 0u; cnt = 0u; mine = 0u;
#pragma unroll
        for (unsigned j = 0; j < 16; ++j) { const unsigned c = xb_ld(&bar[XB_XCNT(j)]); sum += c; cnt += (c > 0u) ? 1u : 0u; mine = (j == x) ? c : mine; }
        if (sum == G) break;
        __builtin_amdgcn_s_sleep(1);
        if ((++sp & 255u) == 0u) { if (xb_ld(&bar[XB_TMO])) break; if (sp > XB_SPIN_CAP) { atomicAdd(&bar[XB_TMO], 1u); break; } }
    }
    nloc = mine > 0u ? mine : 1u; nx = cnt > 0u ? cnt : 1u;
}

__device__ __forceinline__ void xcd_barrier(const XcdBarrier& b) {
    asm volatile("s_waitcnt vmcnt(0)" ::: "memory");
    __syncthreads();
    if (threadIdx.x == 0) {
        unsigned* bar = b.bar;
        __builtin_amdgcn_s_waitcnt(0);
        unsigned nloc = b.st[0], nx = b.st[1];
        if (nloc == 0u) { xcd_barrier_complete(bar, b.x, nloc, nx); b.st[0] = nloc; b.st[1] = nx; }
        const unsigned old = xb_add(&bar[XB_XSUB(b.x)], 1u);
        const unsigned gen = old / nloc;
        if (old + 1u == (gen + 1u) * nloc) {
            __builtin_amdgcn_fence(__ATOMIC_RELEASE, "agent");
            asm volatile("s_waitcnt vmcnt(0)" ::: "memory");
            const unsigned og = xb_add(&bar[XB_TOP], 1u);
            const unsigned tg = og / nx;
            if (og + 1u == (tg + 1u) * nx) xb_add(&bar[XB_TOPGEN], 1u);
            else XB_SPIN(xb_ld(&bar[XB_TOPGEN]) == tg, bar);
            __builtin_amdgcn_fence(__ATOMIC_ACQUIRE, "agent");
            xb_add(&bar[XB_XGEN(b.x)], 1u);
            asm volatile("s_waitcnt vmcnt(0)" ::: "memory");
        } else {
            XB_SPIN(xb_ld(&bar[XB_XGEN(b.x)]) == gen, bar);
            __builtin_amdgcn_fence(__ATOMIC_ACQUIRE, "agent");
            asm volatile("s_waitcnt vmcnt(0)" ::: "memory");
        }
    }
    __syncthreads();
}

__global__ void __launch_bounds__(NTHR, 2) mk_fwd(Params pv) {
    extern __shared__ __attribute__((aligned(16))) unsigned char smem[];
    cg::grid_group grid = cg::this_grid();
    LAS unsigned char* lds = (LAS unsigned char*)smem;
    constexpr int NPH = 1 + DEPTH * 9;
    {
        CParams p = (CParams)__builtin_amdgcn_kernarg_segment_ptr();
        Ctx cx; cx.tid = threadIdx.x; cx.bx = blockIdx.x; asm volatile("" : "+v"(cx.tid)); asm volatile("" : "+s"(cx.bx));
        const int lane = cx.tid & 63, wave = __builtin_amdgcn_readfirstlane(cx.tid >> 6);
        convert_weights(p, cx, 0, 0, lds, wave, lane);
        rope_table(p, cx);
        rowwise_phase(p, cx, ((const float*)p->x), nullptr, nullptr, ((const float*)p->pre_mix_norm), 0, lds, wave, lane);
        if (cx.bx == 0) for (int i = cx.tid; i < XCD_BAR_WORDS; i += NTHR) ((unsigned*)(((unsigned char*)p->ws)))[i] = 0u;
        if (cx.tid == 0) { ((volatile LAS unsigned*)(lds + LDS_BYTES - 16))[0] = 0u; ((volatile LAS unsigned*)(lds + LDS_BYTES - 16))[1] = 0u; }
        grid.sync();
    }
    XcdBarrier xbar = xcd_barrier_post((unsigned*)(((unsigned char*)((CParams)__builtin_amdgcn_kernarg_segment_ptr())->ws)), (volatile LAS unsigned*)(lds + LDS_BYTES - 16));
#ifndef PROBE_MASK
#define PROBE_MASK 0
#endif
#define PROBE_PART 0
    for (int ph2 = 2; ph2 < 2 * NPH; ++ph2) {
        const int ph = ph2 >> 1;
        if ((ph2 & 1) && !((PROBE_MASK >> ((ph - 1) % 9)) & 1)) continue;
        CParams p = (CParams)__builtin_amdgcn_kernarg_segment_ptr();
        asm volatile("" : "+s"(p));
        unsigned char* ws = ((unsigned char*)p->ws);
        Ctx cx; cx.tid = threadIdx.x; cx.bx = blockIdx.x; asm volatile("" : "+v"(cx.tid)); asm volatile("" : "+s"(cx.bx));
        const int tid = cx.tid, lane = tid & 63, wave = __builtin_amdgcn_readfirstlane(tid >> 6);
        const int l = (ph - 1) / 9, kk = (ph - 1) % 9, k = kk == 0 ? 0 : (kk == 1 ? 100 : (kk == 2 ? 2 : (kk == 3 ? 101 : (kk == 4 ? 3 : (kk == 5 ? 4 : (kk == 6 ? 5 : (kk == 7 ? 9 : 10)))))));
        if (k == 0 || k == 3 || k == 5 || k == 9) {
            pg8::Gemm g; pg8::EpiAny E; E.ws = ws; E.k = k; E.cw = ((const float*)p->ffn_conv) + (size_t)l * 3 * DFF2; E.cb = ((const float*)p->ffn_conv_bias) + (size_t)l * DFF2; const size_t wo = (l & 1) ? WS_WODD : 0;
            if (k == 0) { g.A = (const bf16*)((float*)p->out); g.Bt = (const bf16*)(ws + WS_WIN + wo); g.N = NIN; g.K = D; }
            else if (k == 3) { g.A = (const bf16*)((float*)p->out); g.Bt = (const bf16*)(ws + WS_WOUT + wo); g.N = D; g.K = D; }
            else if (k == 9) { g.A = (const bf16*)(ws + WS_ACT); g.Bt = (const bf16*)(ws + WS_WDOWN + wo); g.N = D; g.K = DFF; }
            else { g.A = (const bf16*)((float*)p->out); g.Bt = (const bf16*)(ws + WS_WUP + wo); g.N = DFF2; g.K = D; }
            g.M = M;
            pg8::StaticOrder S; S.init(M, g.N, (int)gridDim.x, cx.bx);
            if (k == 9) {
                pg8::Unit uu; for (int i = 0; S.next(i, uu); ++i) ffn_fixup(p, cx, l, uu.pm);
                asm volatile("s_waitcnt vmcnt(0)" ::: "memory"); __syncthreads();
            }
            pg8::gemm_phase<pg8::EpiAny, pg8::StaticOrder, true, true>(lds, g, S, E, tid);
        } else if (k == 100) {
#ifndef NAIVE_SCAN
            d0_phase(p, cx, l, wave, lane);
            asm volatile("s_waitcnt vmcnt(0)" ::: "memory"); __syncthreads();
            { const int G = gridDim.x; v4u pf0, pf1, pf2, pf3, pf4, pf5; const int u0 = cx.bx;
              pf0 = *(const v4u*)D1_ROWPTR(u0, 0); pf1 = *(const v4u*)D1_ROWPTR(u0, 1); pf2 = *(const v4u*)D1_ROWPTR(u0, 2); pf3 = *(const v4u*)D1_ROWPTR(u0, 3); pf4 = *(const v4u*)D1_ROWPTR(u0, 4); pf5 = *(const v4u*)D1_ROWPTR(u0, 5);
              for (int un = u0; un < BATCH * 4 * 64; un += G) d1_unit(p, cx, un, un + G < BATCH * 4 * 64 ? un + G : -1, pf0, pf1, pf2, pf3, pf4, pf5, lds, wave, lane); }
#endif
        } else if (k == 101) {
            gate_phase(p, cx, l, wave, lane);
        } else if (k == 2) {
            const int bx = cx.bx, G = gridDim.x;
#ifdef NAIVE_SCAN
            if (bx < 32) scan_naive_unit(p, cx, l, bx, lds, wave, lane);
#else
            if (bx < 32 && !((ph2 & 1) && PROBE_PART == 2)) scan_chunked_unit(p, cx, l, bx, lds, wave, lane);
#endif
#ifdef NAIVE_ATTN
            else { for (int it = (bx - 32) * NTHR + tid; it < M * 8; it += (G - 32) * NTHR) attn_naive_item(p, it); }
#else
            if (bx >= 32 && !((ph2 & 1) && PROBE_PART == 1)) { for (int bu = bx - 32; bu < BATCH * 8 * 16; bu += G - 32) { attn_stage(p, cx, bu, lds); attn_mfma_unit(p, bu * 8 + wave, lane, lds); }
                __syncthreads();
                if (l + 1 < DEPTH && !(ph2 & 1)) convert_weights(p, cx, l + 1, 32, lds, wave, lane); }
#endif
        } else if (k == 4) {
            rowwise_phase(p, cx, nullptr, (const bf16*)(ws + WS_Y), ((const float*)p->post_mix_norm) + l * D, ((const float*)p->pre_ffn_norm) + l * D, -1, lds, wave, lane);
        } else {
            if (l + 1 < DEPTH) {
                rowwise_phase(p, cx, nullptr, (const bf16*)(ws + WS_Y2), ((const float*)p->post_ffn_norm) + l * D, ((const float*)p->pre_mix_norm) + (l + 1) * D, l + 1, lds, wave, lane); }
            else rowwise_phase(p, cx, nullptr, (const bf16*)(ws + WS_Y2), ((const float*)p->post_ffn_norm) + l * D, nullptr, -1, lds, wave, lane);
        }
        if (ph2 + 1 < 2 * NPH) xcd_barrier(xbar);
    }
}

extern "C" void kernel_launch(void* const* d_in, const int* in_sizes, int n_in, void* d_out, int out_size, void* d_ws, size_t ws_size, hipStream_t stream) {
    static int grid_blocks = 0;
    if (grid_blocks == 0) {
        if (n_in != 15 || in_sizes[0] != M * D || out_size != M * D || ws_size < WS_NEED) { fprintf(stderr, "kernel_launch: unexpected shapes / workspace (n_in %d, ws %zu)\n", n_in, ws_size); grid_blocks = -1; return; }
        int dev = 0, cus = 0, per_cu = 0;
        hipGetDevice(&dev); hipDeviceGetAttribute(&cus, hipDeviceAttributeMultiprocessorCount, dev);
        if (hipFuncSetAttribute((const void*)mk_fwd, hipFuncAttributeMaxDynamicSharedMemorySize, LDS_BYTES) != hipSuccess) { fprintf(stderr, "kernel_launch: hipFuncSetAttribute failed\n"); grid_blocks = -1; return; }
        if (hipOccupancyMaxActiveBlocksPerMultiprocessor(&per_cu, (const void*)mk_fwd, NTHR, LDS_BYTES) != hipSuccess || per_cu < 1) { fprintf(stderr, "kernel_launch: occupancy query gave %d\n", per_cu); per_cu = 1; }
        (void)hipGetLastError();
        grid_blocks = cus * 1;
    }
    if (grid_blocks < 0) return;
    Params p{};
    p.x = (GAS const float*)d_in[0]; p.pre_mix_norm = (GAS const float*)d_in[1]; p.w_in = (GAS const float*)d_in[2]; p.dn_conv = (GAS const float*)d_in[3]; p.dn_a_log = (GAS const float*)d_in[4];
    p.dn_dt_bias = (GAS const float*)d_in[5]; p.dn_out_norm = (GAS const float*)d_in[6]; p.w_out = (GAS const float*)d_in[7]; p.post_mix_norm = (GAS const float*)d_in[8]; p.pre_ffn_norm = (GAS const float*)d_in[9];
    p.ffn_up = (GAS const float*)d_in[10]; p.ffn_conv = (GAS const float*)d_in[11]; p.ffn_conv_bias = (GAS const float*)d_in[12]; p.ffn_down = (GAS const float*)d_in[13]; p.post_ffn_norm = (GAS const float*)d_in[14];
    p.out = (GAS float*)d_out; p.ws = (GAS unsigned char*)d_ws;
    void* args[] = {&p};
    hipError_t e = hipLaunchCooperativeKernel((const void*)mk_fwd, dim3(grid_blocks), dim3(NTHR), args, LDS_BYTES, stream);
    if (e != hipSuccess) fprintf(stderr, "kernel_launch: cooperative launch failed: %s (grid %d)\n", hipGetErrorString(e), grid_blocks);
}
```
